# Optimizing an MI355X kernel written in HIP

```python
import jax, jax.numpy as jnp
from jax import lax
import numpy as np

D_MODEL = 2048
BATCH = 4
SEQ = 4096
DEPTH = 2

HEAD_DIM = 64
D_SB = D_MODEL // 4
D_FOX = D_MODEL // 2
CONV_CH = D_MODEL // 4
N_SB_HEADS = D_SB // HEAD_DIM
N_FOX_HEADS = D_FOX // HEAD_DIM
CONV_WIDTH = 31
MIX_COLS = 3 * D_SB + 3 * D_FOX + N_FOX_HEADS + 2 * CONV_CH
Q_BLOCK = 128

N_GROUPS = 4
EXPERTS_PER_GROUP = 8
N_EXPERTS = N_GROUPS * EXPERTS_PER_GROUP
TOP_K = 2
D_EXPERT = D_MODEL // 2
MOE_BLOCK = 256

ALPHA = (2 * DEPTH) ** 0.25
INIT_BETA = (8 * DEPTH) ** -0.25
LN_EPS = 1e-5

kernel_name = 'hybrid_sb_fox_conformer_hmoe_deepnorm_adaln'


def _ln(x):
    xf = x.astype(jnp.float32)
    mu = jnp.mean(xf, axis=-1, keepdims=True)
    var = jnp.mean(jnp.square(xf - mu), axis=-1, keepdims=True)
    return ((xf - mu) * lax.rsqrt(var + LN_EPS)).astype(x.dtype)


def _heads(t, n):
    b, s, _ = t.shape
    return t.reshape(b, s, n, HEAD_DIM).transpose(0, 2, 1, 3)


def _merge_blocks(o):
    nb, b, h, blk, dh = o.shape
    return o.transpose(1, 0, 3, 2, 4).reshape(b, nb * blk, h * dh)


def stick_breaking_attention(q, k, v):
    s = q.shape[2]
    scale = HEAD_DIM ** -0.5
    key_pos = jnp.arange(s)

    def block(i):
        q_blk = lax.dynamic_slice_in_dim(q, i * Q_BLOCK, Q_BLOCK, axis=2)
        z = jnp.einsum('bhqd,bhkd->bhqk', q_blk, k).astype(jnp.float32) * scale
        q_pos = i * Q_BLOCK + jnp.arange(Q_BLOCK)
        mask = key_pos[None, :] < q_pos[:, None]
        log_keep = jnp.where(mask, jax.nn.log_sigmoid(-z), 0.0)
        later = lax.cumsum(log_keep, axis=3, reverse=True) - log_keep
        w = jnp.where(mask, jnp.exp(jax.nn.log_sigmoid(z) + later), 0.0)
        return jnp.einsum('bhqk,bhkd->bhqd', w.astype(v.dtype), v)

    return _merge_blocks(lax.map(block, jnp.arange(s // Q_BLOCK)))


def forgetting_attention(q, k, v, log_f):
    s = q.shape[2]
    scale = HEAD_DIM ** -0.5
    key_pos = jnp.arange(s)
    cum = jnp.cumsum(log_f, axis=-1)

    def block(i):
        q_blk = lax.dynamic_slice_in_dim(q, i * Q_BLOCK, Q_BLOCK, axis=2)
        cum_q = lax.dynamic_slice_in_dim(cum, i * Q_BLOCK, Q_BLOCK, axis=2)
        z = jnp.einsum('bhqd,bhkd->bhqk', q_blk, k).astype(jnp.float32) * scale
        logits = z + cum_q[..., :, None] - cum[..., None, :]
        q_pos = i * Q_BLOCK + jnp.arange(Q_BLOCK)
        mask = key_pos[None, :] <= q_pos[:, None]
        p = jax.nn.softmax(jnp.where(mask, logits, -jnp.inf), axis=-1)
        return jnp.einsum('bhqk,bhkd->bhqd', p.astype(v.dtype), v)

    return _merge_blocks(lax.map(block, jnp.arange(s // Q_BLOCK)))


def conformer_conv(a, g, conv_w, conv_b, ln_g, ln_b):
    u = a * jax.nn.sigmoid(g)
    u = lax.conv_general_dilated(
        u, conv_w[:, None, :].astype(u.dtype), window_strides=(1,),
        padding=[(CONV_WIDTH - 1, 0)], dimension_numbers=('NWC', 'WIO', 'NWC'),
        feature_group_count=u.shape[-1]) + conv_b
    u = _ln(u) * ln_g + ln_b
    return jax.nn.silu(u)


def hybrid_mixer(h, w_in, b_forget, conv_w, conv_b, conv_ln_g, conv_ln_b, w_out):
    sizes = [D_SB, D_SB, D_SB, D_FOX, D_FOX, D_FOX, N_FOX_HEADS, CONV_CH, CONV_CH]
    offsets = [int(o) for o in np.cumsum(sizes)[:-1]]
    proj = h @ w_in
    q_sb, k_sb, v_sb, q_fx, k_fx, v_fx, f_logit, glu_a, glu_g = jnp.split(proj, offsets, axis=-1)

    o_sb = stick_breaking_attention(_heads(q_sb, N_SB_HEADS), _heads(k_sb, N_SB_HEADS),
                                    _heads(v_sb, N_SB_HEADS))
    log_f = jax.nn.log_sigmoid((f_logit + b_forget).astype(jnp.float32)).transpose(0, 2, 1)
    o_fx = forgetting_attention(_heads(q_fx, N_FOX_HEADS), _heads(k_fx, N_FOX_HEADS),
                                _heads(v_fx, N_FOX_HEADS), log_f)
    o_cv = conformer_conv(glu_a, glu_g, conv_w, conv_b, conv_ln_g, conv_ln_b)
    return jnp.concatenate([o_sb, o_fx, o_cv], axis=-1) @ w_out


def hierarchical_moe(h, r1_w, r1_b, r2_w, r2_b, w_gate, w_up, w_down):
    b, s, d = h.shape
    ht = h.reshape(b * s, d)
    n_tok = ht.shape[0]
    logits1 = (ht @ r1_w + r1_b).astype(jnp.float32)
    p1 = jax.nn.softmax(logits1, axis=-1)
    grp = jnp.argmax(logits1, axis=-1)
    p_grp = jnp.take_along_axis(p1, grp[:, None], axis=1)
    logits2 = (jnp.einsum('td,gde->tge', ht, r2_w) + r2_b).astype(jnp.float32)
    logits2 = jnp.take_along_axis(logits2, grp[:, None, None], axis=1)[:, 0]
    top_p, top_e = lax.top_k(jax.nn.softmax(logits2, axis=-1), TOP_K)
    weights = (p_grp * top_p / jnp.sum(top_p, axis=-1, keepdims=True)).astype(h.dtype)
    expert = grp[:, None] * EXPERTS_PER_GROUP + top_e

    flat_e = expert.reshape(-1)
    n_assign = flat_e.shape[0]
    order = jnp.argsort(flat_e)
    sorted_e = flat_e[order]
    counts = jnp.bincount(flat_e, length=N_EXPERTS)
    padded = (counts + MOE_BLOCK - 1) // MOE_BLOCK * MOE_BLOCK
    pad_start = jnp.cumsum(padded) - padded
    seg_start = jnp.cumsum(counts) - counts
    dest = pad_start[sorted_e] + jnp.arange(n_assign) - seg_start[sorted_e]
    n_blocks = -(-n_assign // MOE_BLOCK) + N_EXPERTS
    buf_tok = jnp.zeros((n_blocks * MOE_BLOCK,), jnp.int32).at[dest].set((order // TOP_K).astype(jnp.int32))
    block_expert = jnp.zeros((n_blocks,), jnp.int32).at[dest // MOE_BLOCK].set(sorted_e.astype(jnp.int32))
    xb = ht[buf_tok].reshape(n_blocks, MOE_BLOCK, d)

    def expert_block(args):
        xe, e = args
        hid = jax.nn.silu(xe @ w_gate[e]) * (xe @ w_up[e])
        return hid @ w_down[e]

    yb = lax.map(expert_block, (xb, block_expert)).reshape(n_blocks * MOE_BLOCK, d)
    y_assign = jnp.zeros((n_assign, d), h.dtype).at[order].set(yb[dest])
    y = jnp.sum(y_assign.reshape(n_tok, TOP_K, d) * weights[..., None], axis=1)
    return y.reshape(b, s, d)


def setup_inputs(seed: int = 0) -> dict:
    key = jax.random.key(seed)
    ks = jax.random.split(key, 24)
    L, D = DEPTH, D_MODEL
    nrm = lambda k, shape, sc: jax.random.normal(k, shape, jnp.float32) * sc
    return {
        'x': nrm(ks[0], (BATCH, SEQ, D), 1.0),
        'c': nrm(ks[1], (BATCH, D), 1.0),
        'ada_w': nrm(ks[2], (L, D, 6 * D), D ** -0.5),
        'ada_b': nrm(ks[3], (L, 6 * D), 0.01),
        'w_in': nrm(ks[4], (L, D, MIX_COLS), D ** -0.5),
        'b_forget': 1.0 + 4.0 * jax.random.uniform(ks[5], (L, N_FOX_HEADS), jnp.float32),
        'conv_w': nrm(ks[6], (L, CONV_WIDTH, CONV_CH), CONV_WIDTH ** -0.5),
        'conv_b': nrm(ks[7], (L, CONV_CH), 0.01),
        'conv_ln_g': 1.0 + nrm(ks[8], (L, CONV_CH), 0.05),
        'conv_ln_b': nrm(ks[9], (L, CONV_CH), 0.01),
        'w_out': nrm(ks[10], (L, D, D), D ** -0.5 * INIT_BETA),
        'ln1_g': 1.0 + nrm(ks[11], (L, D), 0.05),
        'ln1_b': nrm(ks[12], (L, D), 0.01),
        'r1_w': nrm(ks[13], (L, D, N_GROUPS), D ** -0.5),
        'r1_b': nrm(ks[14], (L, N_GROUPS), 0.01),
        'r2_w': nrm(ks[15], (L, N_GROUPS, D, EXPERTS_PER_GROUP), D ** -0.5),
        'r2_b': nrm(ks[16], (L, N_GROUPS, EXPERTS_PER_GROUP), 0.01),
        'w_gate': nrm(ks[17], (L, N_EXPERTS, D, D_EXPERT), D ** -0.5),
        'w_up': nrm(ks[18], (L, N_EXPERTS, D, D_EXPERT), D ** -0.5),
        'w_down': nrm(ks[19], (L, N_EXPERTS, D_EXPERT, D), D_EXPERT ** -0.5 * INIT_BETA),
        'ln2_g': 1.0 + nrm(ks[20], (L, D), 0.05),
        'ln2_b': nrm(ks[21], (L, D), 0.01),
    }


def reference(x, c, ada_w, ada_b, w_in, b_forget, conv_w, conv_b, conv_ln_g, conv_ln_b,
              w_out, ln1_g, ln1_b, r1_w, r1_b, r2_w, r2_b, w_gate, w_up, w_down,
              ln2_g, ln2_b):
    for l in range(DEPTH):
        mod = jax.nn.silu(c) @ ada_w[l] + ada_b[l]
        sh1, sc1, gt1, sh2, sc2, gt2 = [m[:, None, :] for m in jnp.split(mod, 6, axis=-1)]
        h = _ln(x) * (1.0 + sc1) + sh1
        y = hybrid_mixer(h, w_in[l], b_forget[l], conv_w[l], conv_b[l], conv_ln_g[l],
                         conv_ln_b[l], w_out[l])
        x = _ln(ALPHA * x + gt1 * y) * ln1_g[l] + ln1_b[l]
        h = _ln(x) * (1.0 + sc2) + sh2
        y = hierarchical_moe(h, r1_w[l], r1_b[l], r2_w[l], r2_b[l], w_gate[l], w_up[l], w_down[l])
        x = _ln(ALPHA * x + gt2 * y) * ln2_g[l] + ln2_b[l]
    return x
```

```cpp
#include <hip/hip_runtime.h>
#include <hip/hip_bf16.h>
#include <cstdio>
#include <cstdint>
#include <cmath>
namespace pg8 {
#define PG8_LAS __attribute__((address_space(3)))
typedef unsigned short bf16_t;
typedef short bf16x8 __attribute__((ext_vector_type(8)));
typedef float f32x4 __attribute__((ext_vector_type(4)));
typedef unsigned u32x4 __attribute__((ext_vector_type(4)));
typedef int v4i_t __attribute__((ext_vector_type(4)));
typedef int v8i_t __attribute__((ext_vector_type(8)));
constexpr int BM = 256, BK = 64, HALF = 128, HTB = HALF * BK * 2  , STAGE_BYTES = 8 * HTB, NXCD = 8, WGM = 8;

__host__ __device__ __forceinline__ int lds_byte(int r, int c) { const int st = (r >> 4) * 2 + (c >> 5), rr = r & 15, cc = c & 31, ob = rr * 64 + cc * 2; return st * 1024 + (ob ^ (((ob >> 9) & 1) << 5)); }
__host__ __device__ __forceinline__ void stage_rc(int b, int& R, int& C) { const int st = b / 1024, sb = b % 1024, swz = sb ^ (((sb >> 9) & 1) << 5); R = (st >> 1) * 16 + swz / 64; C = (st & 1) * 32 + (swz % 64) / 2; }
__host__ __device__ __forceinline__ int perm32(int rho) { const int n = rho >> 4, i = rho & 15; return 8 * (i >> 2) + 4 * n + (i & 3); }

struct Unit { int pm, pn, e, rows; };

__device__ __forceinline__ unsigned cvt_pk_bf16(float lo, float hi) { unsigned r; asm volatile("v_cvt_pk_bf16_f32 %0, %1, %2" : "=v"(r) : "v"(lo), "v"(hi)); return r; }

__device__ __forceinline__ void glds_s(const char* sbase, unsigned voff, unsigned lds_dst) { unsigned keep;
    asm volatile("s_mov_b32 %0, m0\n\ts_mov_b32 m0, %3\n\ts_nop 0\n\tglobal_load_lds_dwordx4 %1, %2\n\ts_mov_b32 m0, %0" : "=&s"(keep) : "v"(voff), "s"(sbase), "s"(lds_dst) : "memory"); }
template <class Epi, class Sched, bool ALIGN_EPI, bool FP8 = false, int SCW = 127, int SCA = 127>
__device__ __forceinline__ void gemm_phase(PG8_LAS unsigned char* lds, const char* Abase, const int K, const Sched& S, const Epi& E, const int tid_in) {
    int tid = tid_in; asm volatile("" : "+v"(tid), "+s"(Abase));
    const int wid = __builtin_amdgcn_readfirstlane(tid >> 6), lane = tid & 63, wr = wid >> 2, wc = wid & 3, fr = lane & 15, fq = lane >> 4;
    int scw = SCW, sca = SCA; asm volatile("" : "+v"(scw), "+v"(sca));
    (void)scw; (void)sca;
    const int nt = K / BK;
    int Rs[2], Cs[2]; unsigned voffB[2];
#pragma unroll
    for (int i = 0; i < 2; ++i) { int R, C; stage_rc(tid * 16 + i * 8192, R, C); const int Rb = Epi::PERM ? ((R & ~31) + perm32(R & 31)) : R; Rs[i] = R; Cs[i] = C; voffB[i] = (unsigned)(Rb * K + C) * 2u; }
    const size_t kstep = (size_t)(BK * 2);
    const size_t hstep = (size_t)HALF * K * 2;
    const unsigned ldsb = (unsigned)(size_t)lds + (unsigned)wid * 1024u;
    const int aoff = lds_byte(wr * 64 + fr, fq * 8), boff = lds_byte(wc * 32 + fr, fq * 8) + 4 * HTB;
    int aoff_ = aoff, boff_ = boff; asm volatile("" : "+v"(aoff_), "+v"(boff_));
#define PG8_SA(b, h) (((b) * 2 + (h)) * HTB)
#define PG8_SB(b, h) ((4 + (b) * 2 + (h)) * HTB)
#define PG8_SBR(b, h) (((b) * 2 + (h)) * HTB)
#define PG8_STAGE(bufoff, gbase, voff) do { _Pragma("unroll") for (int _i = 0; _i < 2; ++_i) \
        glds_s((const char*)(gbase), (voff)[_i], ldsb + (unsigned)((bufoff) + _i * 8192)); } while (0)
#define PG8_L16(off) (*(const PG8_LAS v4i_t*)(lds + (off)))
#define PG8_CAT(lo, hi) __builtin_shufflevector(lo, hi, 0, 1, 2, 3, 4, 5, 6, 7)
#define PG8_LDA(dst, b, h) do { if constexpr (FP8) { _Pragma("unroll") for (int m = 0; m < 4; ++m) dst##8[m] = PG8_CAT(PG8_L16(aoff_ + PG8_SA(b, h) + m * 2048), PG8_L16(aoff_ + PG8_SA(b, h) + m * 2048 + 1024)); } \
        else { _Pragma("unroll") for (int m = 0; m < 4; ++m) _Pragma("unroll") for (int k = 0; k < 2; ++k) dst[m][k] = *(const PG8_LAS bf16x8*)(lds + aoff_ + (PG8_SA(b, h) + m * 2048 + k * 1024)); } } while (0)
#define PG8_LDB(dst, b, h) do { if constexpr (FP8) { _Pragma("unroll") for (int n = 0; n < 2; ++n) dst##8[n] = PG8_CAT(PG8_L16(boff_ + PG8_SBR(b, h) + n * 2048), PG8_L16(boff_ + PG8_SBR(b, h) + n * 2048 + 1024)); } \
        else { _Pragma("unroll") for (int n = 0; n < 2; ++n) _Pragma("unroll") for (int k = 0; k < 2; ++k) dst[n][k] = *(const PG8_LAS bf16x8*)(lds + boff_ + (PG8_SBR(b, h) + n * 2048 + k * 1024)); } } while (0)
#define PG8_MMA(ai, bj, At, Bt) do { __builtin_amdgcn_s_setprio(1); \
        if constexpr (FP8) { _Pragma("unroll") for (int m = 0; m < 4; ++m) _Pragma("unroll") for (int n = 0; n < 2; ++n) \
            { if constexpr (SCW == 0) acc[ai][bj][m][n] = __builtin_amdgcn_mfma_scale_f32_16x16x128_f8f6f4(Bt##8[n], At##8[m], acc[ai][bj][m][n], 0, 0, 0, 0, 0, 0); \
              else acc[ai][bj][m][n] = __builtin_amdgcn_mfma_scale_f32_16x16x128_f8f6f4(Bt##8[n], At##8[m], acc[ai][bj][m][n], 0, 0, 0, scw, 0, sca); } } \
        else { _Pragma("unroll") for (int m = 0; m < 4; ++m) _Pragma("unroll") for (int n = 0; n < 2; ++n) _Pragma("unroll") for (int k = 0; k < 2; ++k) \
            acc[ai][bj][m][n] = __builtin_amdgcn_mfma_f32_16x16x32_bf16(Bt[n][k], At[m][k], acc[ai][bj][m][n], 0, 0, 0); } \
        __builtin_amdgcn_s_setprio(0); } while (0)
#define PG8_WAIT_V(n) asm volatile("s_waitcnt vmcnt(" #n ")" ::: "memory")
#define PG8_WAIT_L(n) asm volatile("s_waitcnt lgkmcnt(" #n ")" ::: "memory")
#define PG8_BAR __builtin_amdgcn_s_barrier()
#define PG8_SCHED __builtin_amdgcn_sched_barrier(0)
    Unit cur, nxt; int ui = 0;
    if (!S.next(0, cur)) return;
    f32x4 acc[2][2][4][2];
#pragma unroll
    for (int a = 0; a < 2; ++a)
#pragma unroll
        for (int b = 0; b < 2; ++b)
#pragma unroll
            for (int m = 0; m < 4; ++m)
#pragma unroll
                for (int n = 0; n < 2; ++n) { float z0, z1, z2, z3; asm volatile("v_mov_b32 %0, 0\n\tv_mov_b32 %1, 0\n\tv_mov_b32 %2, 0\n\tv_mov_b32 %3, 0" : "=v"(z0), "=v"(z1), "=v"(z2), "=v"(z3)); acc[a][b][m][n] = (f32x4){z0, z1, z2, z3}; }
    bf16x8 At[4][2], B0[2][2], B1[2][2]; v8i_t At8[4], B08[2], B18[2];
    unsigned cvA[2][2]; int pf[4];
    S.a_offs(cur, Rs[0], Cs[0], Rs[1], Cs[1], cvA);
    const char* cB = S.b_base(cur);
    PG8_STAGE(PG8_SB(0, 0), cB, voffB); PG8_STAGE(PG8_SB(0, 1), cB + hstep, voffB); PG8_STAGE(PG8_SA(0, 0), Abase, cvA[0]); PG8_STAGE(PG8_SA(0, 1), Abase, cvA[1]);
    if (wr == 1) PG8_BAR;
    PG8_WAIT_V(2); PG8_BAR;
    PG8_STAGE(PG8_SB(1, 0), cB + kstep, voffB); PG8_STAGE(PG8_SA(1, 0), Abase + kstep, cvA[0]); PG8_STAGE(PG8_SB(1, 1), cB + hstep + kstep, voffB);
    PG8_WAIT_V(6); PG8_BAR;
    for (;;) {
        const bool has_next = S.next(ui + 1, nxt);
        const char* nB = cB;
        if (has_next) nB = S.b_base(nxt);
#pragma unroll 1
        for (int t = 0; t < nt; t += 2) {
            const bool last = (t == nt - 2);
            const char* a1 = Abase + (size_t)(t + 1) * kstep;
            const char* a2 = last ? Abase : Abase + (size_t)(t + 2) * kstep; const char* b2 = last ? nB : cB + (size_t)(t + 2) * kstep;
            const char* a3 = a2 + kstep; const char* b3 = b2 + kstep;
            if constexpr (Sched::PREF) { if (last && has_next) { int t2 = tid; asm volatile("" : "+v"(t2)); int R0, C0, R1, C1; stage_rc(t2 * 16, R0, C0); stage_rc(t2 * 16 + 8192, R1, C1); S.a_pref(nxt, R0, R1, pf); } }
            PG8_LDB(B0, 0, 0); PG8_LDB(B1, 0, 1); PG8_SCHED; PG8_LDA(At, 0, 0); PG8_STAGE(PG8_SA(1, 1), a1, cvA[1]);
            PG8_WAIT_V(8); PG8_WAIT_L(0); PG8_BAR; PG8_MMA(0, 0, At, B0); PG8_MMA(0, 1, At, B1); PG8_BAR; PG8_SCHED;
            if (last && has_next) {
                int t2 = tid; asm volatile("" : "+v"(t2));
                int R0, C0, R1, C1; stage_rc(t2 * 16, R0, C0); stage_rc(t2 * 16 + 8192, R1, C1);
                if constexpr (Sched::PREF) { asm volatile("s_waitcnt vmcnt(2)" : "+v"(pf[0]), "+v"(pf[1]), "+v"(pf[2]), "+v"(pf[3]) :: "memory"); S.a_offs_pf(pf, C0, C1, cvA); }
                else S.a_offs(nxt, R0, C0, R1, C1, cvA); }
            PG8_LDA(At, 0, 1); PG8_STAGE(PG8_SB(0, 0), b2, voffB); PG8_STAGE(PG8_SB(0, 1), b2 + hstep, voffB); PG8_STAGE(PG8_SA(0, 0), a2, cvA[0]);
            PG8_WAIT_V(8); PG8_WAIT_L(0); PG8_BAR; PG8_MMA(1, 0, At, B0); PG8_MMA(1, 1, At, B1); PG8_BAR; PG8_SCHED;
            PG8_LDB(B0, 1, 0); PG8_LDB(B1, 1, 1); PG8_SCHED; PG8_LDA(At, 1, 0); PG8_STAGE(PG8_SA(0, 1), a2, cvA[1]);
            PG8_WAIT_V(8); PG8_WAIT_L(0); PG8_BAR; PG8_MMA(0, 0, At, B0); PG8_MMA(0, 1, At, B1); PG8_BAR; PG8_SCHED;
            PG8_LDA(At, 1, 1); PG8_STAGE(PG8_SB(1, 0), b3, voffB); PG8_STAGE(PG8_SB(1, 1), b3 + hstep, voffB); PG8_STAGE(PG8_SA(1, 0), a3, cvA[0]);
            PG8_WAIT_V(8); PG8_WAIT_L(0); PG8_BAR; PG8_MMA(1, 0, At, B0); PG8_MMA(1, 1, At, B1); PG8_BAR; PG8_SCHED;
        }
        if constexpr (ALIGN_EPI) { if (wr == 0) PG8_BAR; }
        { int t2 = tid; asm volatile("" : "+v"(t2)); const int w2 = __builtin_amdgcn_readfirstlane(t2 >> 6), l2 = t2 & 63;
          if constexpr (FP8 && SCW == 0) {
#pragma unroll
              for (int a = 0; a < 2; ++a)
#pragma unroll
                  for (int b = 0; b < 2; ++b)
#pragma unroll
                      for (int m = 0; m < 4; ++m)
#pragma unroll
                          for (int n = 0; n < 2; ++n) acc[a][b][m][n] = acc[a][b][m][n] * (1.0f / 256.0f); }
          E(acc, cur, w2 >> 2, w2 & 3, l2 & 15, l2 >> 4); }
        if (!has_next) break;
#pragma unroll
        for (int a = 0; a < 2; ++a)
#pragma unroll
            for (int b = 0; b < 2; ++b)
#pragma unroll
                for (int m = 0; m < 4; ++m)
#pragma unroll
                    for (int n = 0; n < 2; ++n) { float z0, z1, z2, z3; asm volatile("v_mov_b32 %0, 0\n\tv_mov_b32 %1, 0\n\tv_mov_b32 %2, 0\n\tv_mov_b32 %3, 0" : "=v"(z0), "=v"(z1), "=v"(z2), "=v"(z3)); acc[a][b][m][n] = (f32x4){z0, z1, z2, z3}; }
        cur = nxt; cB = nB; ++ui;
        if constexpr (ALIGN_EPI) { if (wr == 1) PG8_BAR; }
    }
    PG8_WAIT_V(0);
    if constexpr (!ALIGN_EPI) { if (wr == 0) PG8_BAR; }
    PG8_BAR;
#undef PG8_SA
#undef PG8_SB
#undef PG8_SBR
#undef PG8_STAGE
#undef PG8_LDA
#undef PG8_LDB
#undef PG8_MMA
#undef PG8_CAT
#undef PG8_L16
#undef PG8_WAIT_V
#undef PG8_WAIT_L
#undef PG8_BAR
#undef PG8_SCHED
}
}
namespace attn_body {
using bf16=__hip_bfloat16;
using bf16x8=__attribute__((ext_vector_type(8)))short;
using s16x4=__attribute__((ext_vector_type(4)))short;
using f32x16=__attribute__((ext_vector_type(16)))float;
using u32x4=__attribute__((ext_vector_type(4)))unsigned;
typedef float f32x4a __attribute__((ext_vector_type(4)));
constexpr int SEQ=4096,D=64,DM=5632;
constexpr int OPITCH=2048;
constexpr int NW=8,QBLK=32,QB=QBLK*NW,KVBLK=64,NQB=SEQ/QB;
__device__ __forceinline__ int crow(int r,int hi){return (r&3)+8*(r>>2)+4*hi;}
#define SBAR() __builtin_amdgcn_sched_barrier(0)
__device__ __forceinline__ void cmask(f32x16&p0,f32x16&p1,int jb,int qrel,int hi){
  const float NEG=-INFINITY; int kb=64*jb+4*hi;
  #pragma unroll
  for(int r=0;r<16;++r){int kv=kb+(r&3)+8*(r>>2); if(kv>qrel)p0[r]=NEG; if(kv+32>qrel)p1[r]=NEG;}
}
__device__ __forceinline__ void cmask_strict(f32x16&p0,f32x16&p1,int jb,int qrel,int hi){
  const float NEG=-INFINITY; int kb=64*jb+4*hi;
  #pragma unroll
  for(int r=0;r<16;++r){int kv=kb+(r&3)+8*(r>>2); if(kv>=qrel)p0[r]=NEG; if(kv+32>=qrel)p1[r]=NEG;}
}

constexpr int NSLOT=3, SLOTB=8192;
constexpr int LDS_K=0, LDS_V=NSLOT*SLOTB, LDS_WS=2*NSLOT*SLOTB, LDS_OST=LDS_WS+NW*64*4, LDS_CK=LDS_OST+NW*4096, LDS_BYTES=LDS_CK+(SEQ+64)*4;
constexpr float C2=0.125f*1.4426950408889634f;
constexpr float WIN_T=40.0f;
__device__ __forceinline__ void glds16(const void*gsrc,unsigned lds_dst){unsigned keep;
  asm volatile("s_mov_b32 %0, m0\n\ts_mov_b32 m0, %2\n\ts_nop 0\n\tglobal_load_lds_dwordx4 %1, off\n\ts_mov_b32 m0, %0":"=&s"(keep):"v"(gsrc),"s"(lds_dst):"memory");}
__device__ __forceinline__ float max3f(float a,float b,float c){float r;asm("v_max3_f32 %0, %1, %2, %3":"=v"(r):"v"(a),"v"(b),"v"(c));return r;}
__device__ __forceinline__ float max2f(float a,float b){float r;asm("v_max_f32_e32 %0, %1, %2":"=v"(r):"v"(a),"v"(b));return r;}
__device__ __forceinline__ float fadd_s(float a,float b){float r;asm("v_add_f32_e32 %0, %1, %2":"=v"(r):"v"(a),"v"(b));return r;}
__device__ __forceinline__ float fsub_s(float a,float b){float r;asm("v_sub_f32_e32 %0, %1, %2":"=v"(r):"v"(a),"v"(b));return r;}
typedef float f32x2_t __attribute__((ext_vector_type(2))); typedef __bf16 bf16x2_t __attribute__((ext_vector_type(2)));
__device__ __forceinline__ unsigned cvtpk_s(float lo,float hi){f32x2_t v={lo,hi};bf16x2_t b=__builtin_convertvector(v,bf16x2_t);return __builtin_bit_cast(unsigned,b);}
#define WAIT_BAR(N) asm volatile("s_waitcnt vmcnt(" #N ") lgkmcnt(0)\n\ts_barrier":::"memory")

typedef __attribute__((address_space(3))) const char* lds_cptr;
typedef short v4i16_t __attribute__((ext_vector_type(4)));
__device__ __forceinline__ void kload8(bf16x8*kf,lds_cptr kp){
  kf[0]=*(const __attribute__((address_space(3))) bf16x8*)(kp);      kf[1]=*(const __attribute__((address_space(3))) bf16x8*)(kp+512);
  kf[2]=*(const __attribute__((address_space(3))) bf16x8*)(kp+2048); kf[3]=*(const __attribute__((address_space(3))) bf16x8*)(kp+2560);
  kf[4]=*(const __attribute__((address_space(3))) bf16x8*)(kp+4096); kf[5]=*(const __attribute__((address_space(3))) bf16x8*)(kp+4608);
  kf[6]=*(const __attribute__((address_space(3))) bf16x8*)(kp+6144); kf[7]=*(const __attribute__((address_space(3))) bf16x8*)(kp+6656);
}
__device__ __forceinline__ void kload2(bf16x8*kf,lds_cptr kp,int j){ kf[2*j]=*(const __attribute__((address_space(3))) bf16x8*)(kp+j*2048); kf[2*j+1]=*(const __attribute__((address_space(3))) bf16x8*)(kp+j*2048+512); }
__device__ __forceinline__ s16x4 vtr(lds_cptr p){ return __builtin_bit_cast(s16x4,__builtin_amdgcn_ds_read_tr16_b64_v4i16((__attribute__((address_space(3))) v4i16_t*)p)); }
__device__ __forceinline__ float rowmax(const f32x16&p0,const f32x16&p1){
  float a=max3f(p0[0],p0[1],p1[0]),b=max3f(p0[2],p0[3],p1[1]);a=max3f(a,p1[2],p1[3]);
  #pragma unroll
  for(int r=4;r<16;r+=4){a=max3f(a,p0[r],p0[r+1]);b=max3f(b,p0[r+2],p0[r+3]);a=max3f(a,p1[r],p1[r+1]);b=max3f(b,p1[r+2],p1[r+3]);}
  const float m=max2f(a,b);
  auto rr=__builtin_amdgcn_permlane32_swap(__float_as_uint(m),__float_as_uint(m),false,false);
  return max2f(__uint_as_float(rr[0]),__uint_as_float(rr[1]));
}
__device__ __forceinline__ void pv(f32x16*o,int vb,bf16x8 pa0,bf16x8 pa1,bf16x8 pa2,bf16x8 pa3){
  #pragma unroll
  for(int d0=0;d0<2;++d0){s16x4 lo[4],hi[4];
    #pragma unroll
    for(int ks=0;ks<4;++ks){
      asm volatile("ds_read_b64_tr_b16 %0,%1 offset:%c2":"=&v"(lo[ks]):"v"(vb),"i"(d0*4096+ks*1024):"memory");
      asm volatile("ds_read_b64_tr_b16 %0,%1 offset:%c2":"=&v"(hi[ks]):"v"(vb),"i"(d0*4096+ks*1024+512):"memory");}
    asm volatile("s_waitcnt lgkmcnt(0)":::"memory");SBAR();
    #define PK(k) (bf16x8){lo[k][0],lo[k][1],lo[k][2],lo[k][3],hi[k][0],hi[k][1],hi[k][2],hi[k][3]}
    o[d0]=__builtin_amdgcn_mfma_f32_32x32x16_bf16(pa0,PK(0),o[d0],0,0,0);
    o[d0]=__builtin_amdgcn_mfma_f32_32x32x16_bf16(pa1,PK(1),o[d0],0,0,0);
    o[d0]=__builtin_amdgcn_mfma_f32_32x32x16_bf16(pa2,PK(2),o[d0],0,0,0);
    o[d0]=__builtin_amdgcn_mfma_f32_32x32x16_bf16(pa3,PK(3),o[d0],0,0,0);
    #undef PK
  }
}
constexpr float O_SCALE=4.0f;
typedef unsigned u32x2_t __attribute__((ext_vector_type(2)));
__device__ __forceinline__ u32x2_t cvt8_fp8(const u32x4 v){
  const float a0=__uint_as_float(v.x<<16)*O_SCALE,a1=__uint_as_float(v.x&0xffff0000u)*O_SCALE,a2=__uint_as_float(v.y<<16)*O_SCALE,a3=__uint_as_float(v.y&0xffff0000u)*O_SCALE;
  const float a4=__uint_as_float(v.z<<16)*O_SCALE,a5=__uint_as_float(v.z&0xffff0000u)*O_SCALE,a6=__uint_as_float(v.w<<16)*O_SCALE,a7=__uint_as_float(v.w&0xffff0000u)*O_SCALE;
  int p=(int)v.x,q=(int)v.y; p=__builtin_amdgcn_cvt_pk_fp8_f32(a0,a1,p,false); p=__builtin_amdgcn_cvt_pk_fp8_f32(a2,a3,p,true); q=__builtin_amdgcn_cvt_pk_fp8_f32(a4,a5,q,false); q=__builtin_amdgcn_cvt_pk_fp8_f32(a6,a7,q,true);
  return (u32x2_t){(unsigned)p,(unsigned)q}; }
#define ATTN_STORE8(p,v) (*(__attribute__((address_space(1))) u32x2_t*)(p)=cvt8_fp8(v))

template<int THRL> __device__ __forceinline__ void fox_unit(int b,int qb,const bf16*Qh,const bf16*__restrict__ Kh_,const bf16*__restrict__ Vh_,unsigned char*Oh,const float*__restrict__ cumh,const float*__restrict__ cendh,char*shm,const int tid_in){
  int tid=tid_in;
  asm volatile("":"+s"(Qh),"+s"(Kh_),"+s"(Vh_),"+s"(Oh),"+s"(cumh),"+s"(cendh),"+v"(tid));
  const int lane=tid&63,r32=lane&31,hi=lane>>5; const int wid=__builtin_amdgcn_readfirstlane(tid>>6);
  const long rowbase=(long)b*SEQ; const int q0=qb*QB;
  const bf16*Qw=Qh+(rowbase+q0+wid*QBLK)*DM;
  const int NTfull=(q0+QB)/KVBLK; int t_lo;
  const bool ckld=tid*8<NTfull*KVBLK; f32x4a cka,ckc; if(ckld){ cka=*(const __attribute__((address_space(1))) f32x4a*)(cumh+tid*8); ckc=*(const __attribute__((address_space(1))) f32x4a*)(cumh+tid*8+4); }
  { const float c0=*(const __attribute__((address_space(1))) float*)(cumh+q0); bool far=false;
    if(lane<NTfull) far=(c0-*(const __attribute__((address_space(1))) float*)(cendh+lane))<-WIN_T;
    t_lo=__builtin_amdgcn_readfirstlane((int)__popcll(__ballot(far)))&~1; if(t_lo>NTfull-4)t_lo=NTfull-4; }
  const bf16*Kh=Kh_+(rowbase+(long)t_lo*KVBLK)*DM,*Vh=Vh_+(rowbase+(long)t_lo*KVBLK)*DM;
  const unsigned lds0=(unsigned)(uintptr_t)shm;
  float*wsf=(float*)(shm+LDS_WS)+wid*64;
  const lds_cptr shm3=(lds_cptr)shm;
  if(ckld){ __attribute__((address_space(3))) f32x4a* dst=(__attribute__((address_space(3))) f32x4a*)(shm3+LDS_CK+tid*32); dst[0]=cka; dst[1]=ckc; }
  const float cq_l=*(const __attribute__((address_space(1))) float*)(cumh+q0+wid*QBLK+r32);
  const bf16*ksrc=Kh+(long)lane*DM+wid*8;
  const bf16*vsrc=Vh+(long)(16*(wid&3)+(lane>>2))*DM+(wid>>2)*32+(lane&3)*8;
  const unsigned kdst=lds0+LDS_K+wid*1024, vdst=lds0+LDS_V+wid*1024;
  #define DMA_K(t,slot) glds16(ksrc+(long)(t)*KVBLK*DM,(unsigned)__builtin_amdgcn_readfirstlane(kdst+(slot)))
  #define DMA_V(t,slot) glds16(vsrc+(long)(t)*KVBLK*DM,(unsigned)__builtin_amdgcn_readfirstlane(vdst+(slot)))
  const int vb0=(int)(lds0+LDS_V)+((lane>>4)&1)*32+(lane&3)*8+(4*hi+((lane&15)>>2))*64;
  bf16x8 kf[8];
  const lds_cptr kp0=shm3+LDS_K+hi*1024+r32*16; const lds_cptr vp0=shm3+LDS_V+((lane>>4)&1)*32+(lane&3)*8+(4*hi+((lane&15)>>2))*64;
  const lds_cptr ckp0=shm3+LDS_CK+t_lo*(KVBLK*4)+hi*16;
  const int NT=NTfull-t_lo;
  DMA_K(0,0);DMA_V(0,0);DMA_K(1,SLOTB);
  bf16x8 qr[4];
  #pragma unroll
  for(int d0=0;d0<4;++d0)qr[d0]=*(const __attribute__((address_space(1))) bf16x8*)(&Qw[(long)r32*DM+d0*16+hi*8]);
  float mhat=0.f,l_reg=0.f,cbase=cq_l;f32x16 o[2];o[0]=f32x16{};o[1]=f32x16{};
  const int qrel=wid*QBLK+r32;
  #define CKG(tt,g) (*(const __attribute__((address_space(3))) f32x4a*)(ckp0+(tt)*256+(g)*32))
  #define CINIT(X0,X1,tt) do{ _Pragma("unroll") for(int g_=0;g_<4;++g_){ const f32x4a a_=CKG(tt,g_), c_=CKG(tt,g_+4); \
      X0[4*g_]=cbase-a_.x; X0[4*g_+1]=cbase-a_.y; X0[4*g_+2]=cbase-a_.z; X0[4*g_+3]=cbase-a_.w; \
      X1[4*g_]=cbase-c_.x; X1[4*g_+1]=cbase-c_.y; X1[4*g_+2]=cbase-c_.z; X1[4*g_+3]=cbase-c_.w; } }while(0)
  #define CMASK(P0,P1,t) do{int jb_=(t)-(NT-4); if(jb_>=0)cmask(P0,P1,jb_,qrel,hi);}while(0)
  bool resc=false;
  #define START(P0,P1) do{ const float rm=rowmax(P0,P1); resc=false; \
    { const float dl=rm; mhat=fadd_s(mhat,dl); cbase=cq_l-mhat; \
      _Pragma("unroll") for(int r=0;r<16;++r){P0[r]=fsub_s(P0[r],dl);P1[r]=fsub_s(P1[r],dl);} } \
    _Pragma("unroll") for(int r=0;r<16;++r)P0[r]=__builtin_amdgcn_exp2f(P0[r]); }while(0)
  #define RESC() do{ if(resc){ asm volatile("s_waitcnt lgkmcnt(0)":::"memory"); \
      _Pragma("unroll") for(int d_=0;d_<2;++d_) _Pragma("unroll") for(int r=0;r<16;++r)o[d_][r]*=wsf[crow(r,hi)]; } }while(0)
  f32x16 pA0,pA1,pB0,pB1;
  int sl_prev=0,sl_cur=0,sl_next=SLOTB;
  #define ROT() do{sl_prev=sl_cur;sl_cur=sl_next;sl_next=(sl_next==(NSLOT-1)*SLOTB)?0:sl_next+SLOTB;}while(0)
  DMA_K(2,2*SLOTB);
  WAIT_BAR(3);
  CINIT(pA0,pA1,0);
  { kload8(kf,kp0);
    #pragma unroll
    for(int d0=0;d0<4;++d0){ pA0=__builtin_amdgcn_mfma_f32_32x32x16_bf16(kf[2*d0],qr[d0],pA0,0,0,0); pA1=__builtin_amdgcn_mfma_f32_32x32x16_bf16(kf[2*d0+1],qr[d0],pA1,0,0,0); } }
  asm volatile("s_nop 15\n\ts_nop 7":"+v"(pA0),"+v"(pA1));CMASK(pA0,pA1,0);
  START(pA0,pA1);
  _Pragma("unroll") for(int r=0;r<16;++r)pA1[r]=__builtin_amdgcn_exp2f(pA1[r]);
  WAIT_BAR(0);
  DMA_K(3,0);DMA_V(1,SLOTB);
  ROT();
  kload8(kf,kp0+sl_cur);
  WAIT_BAR(2);
  s16x4 vlo[8],vhi[8]; u32x4 pw0,pw1,pw2,pw3;
  #define PKW(P,B) cvtpk_s(P[B],P[B+1])
  #define PAF(k) __builtin_bit_cast(bf16x8,pw##k)
  #define VFR(i) (bf16x8){vlo[i][0],vlo[i][1],vlo[i][2],vlo[i][3],vhi[i][0],vhi[i][1],vhi[i][2],vhi[i][3]}
  #define PIN(x) asm volatile("":"+v"(x))
  #define MX3(a,b,c) __builtin_fmaxf(__builtin_fmaxf((a),(b)),(c))
  #define GAPA(MF,A0,A1,A2,A3,W0,W1,PW) do{ MF; sacc+=A0; sacc+=A1; sacc+=A2; sacc+=A3; PIN(sacc); W0; W1; PIN(PW); SBAR(); }while(0)
  #define EX(v) __builtin_amdgcn_exp2f(v)
  #define GAPB(MF,X,B) do{ MF; X[B]=EX(X[B]); X[B+1]=EX(X[B+1]); X[B+2]=EX(X[B+2]); X[B+3]=EX(X[B+3]); PIN(X); SBAR(); }while(0)
  #define VRD(i) do{ vlo[i]=vtr(vp_+(((i)>>2)*4096+((i)&3)*1024)); vhi[i]=vtr(vp_+(((i)>>2)*4096+((i)&3)*1024+512)); }while(0)
  #define KRD(G,j) do{ if(G){ kload2(kf,kp0+sl_next,j); SBAR(); } }while(0)
  #define CKL(P0,P1,t,g_) do{ const f32x4a a_=CKG((t)+1,g_), c_=CKG((t)+1,(g_)+4); P0[4*(g_)]=a_.x;P0[4*(g_)+1]=a_.y;P0[4*(g_)+2]=a_.z;P0[4*(g_)+3]=a_.w; P1[4*(g_)]=c_.x;P1[4*(g_)+1]=c_.y;P1[4*(g_)+2]=c_.z;P1[4*(g_)+3]=c_.w; }while(0)
  #define CKS(P0,P1,g_) do{ P0[4*(g_)]=cbase-P0[4*(g_)];P0[4*(g_)+1]=cbase-P0[4*(g_)+1];P0[4*(g_)+2]=cbase-P0[4*(g_)+2];P0[4*(g_)+3]=cbase-P0[4*(g_)+3]; \
      P1[4*(g_)]=cbase-P1[4*(g_)];P1[4*(g_)+1]=cbase-P1[4*(g_)+1];P1[4*(g_)+2]=cbase-P1[4*(g_)+2];P1[4*(g_)+3]=cbase-P1[4*(g_)+3]; }while(0)
  #define STEP(C0,C1,P0,P1,t,GK,GV,GL) do{ SBAR(); \
    const lds_cptr vp_=vp0+sl_prev; \
    CINIT(C0,C1,t); \
    VRD(0); SBAR(); float sacc=(P0[0]+P0[1]); \
    GAPA(C0=__builtin_amdgcn_mfma_f32_32x32x16_bf16(kf[0],qr[0],C0,0,0,0), P0[2],P0[3],P0[4],P0[5],     pw0[0]=PKW(P0,0), pw0[1]=PKW(P0,2), pw0); \
    VRD(4); SBAR(); GAPA(C1=__builtin_amdgcn_mfma_f32_32x32x16_bf16(kf[1],qr[0],C1,0,0,0), P0[6],P0[7],P0[8],P0[9],     pw0[2]=PKW(P0,4), pw0[3]=PKW(P0,6), pw0); \
    VRD(1); SBAR(); GAPA(C0=__builtin_amdgcn_mfma_f32_32x32x16_bf16(kf[2],qr[1],C0,0,0,0),   P0[10],P0[11],P0[12],P0[13], pw1[0]=PKW(P0,8), pw1[1]=PKW(P0,10), pw1); \
    VRD(5); SBAR(); GAPA(C1=__builtin_amdgcn_mfma_f32_32x32x16_bf16(kf[3],qr[1],C1,0,0,0),   P0[14],P0[15],P1[0],P1[1],   pw1[2]=PKW(P0,12),pw1[3]=PKW(P0,14), pw1); \
    VRD(2); SBAR(); GAPA(C0=__builtin_amdgcn_mfma_f32_32x32x16_bf16(kf[4],qr[2],C0,0,0,0),   P1[2],P1[3],P1[4],P1[5],     pw2[0]=PKW(P1,0), pw2[1]=PKW(P1,2), pw2); \
    VRD(6); SBAR(); GAPA(C1=__builtin_amdgcn_mfma_f32_32x32x16_bf16(kf[5],qr[2],C1,0,0,0),   P1[6],P1[7],P1[8],P1[9],     pw2[2]=PKW(P1,4), pw2[3]=PKW(P1,6), pw2); \
    VRD(3); SBAR(); GAPA(C0=__builtin_amdgcn_mfma_f32_32x32x16_bf16(kf[6],qr[3],C0,0,0,0),   P1[10],P1[11],P1[12],P1[13], pw3[0]=PKW(P1,8), pw3[1]=PKW(P1,10), pw3); \
    VRD(7); SBAR(); GAPA(C1=__builtin_amdgcn_mfma_f32_32x32x16_bf16(kf[7],qr[3],C1,0,0,0),   P1[14],P1[15],0.f,0.f,       pw3[2]=PKW(P1,12),pw3[3]=PKW(P1,14), pw3); \
    l_reg+=sacc; \
    if(GK){DMA_K((t)+3,sl_cur);} if(GV){DMA_V((t)+1,sl_next);} \
    CMASK(C0,C1,t); \
    { float a=MX3(C0[0],C0[1],C1[0]),b=MX3(C0[2],C0[3],C1[1]); a=MX3(a,C1[2],C1[3]); \
      _Pragma("unroll") for(int r=4;r<16;r+=4){a=MX3(a,C0[r],C0[r+1]);b=MX3(b,C0[r+2],C0[r+3]);a=MX3(a,C1[r],C1[r+1]);b=MX3(b,C1[r+2],C1[r+3]);} \
      float rm=__builtin_fmaxf(a,b); { auto rr=__builtin_amdgcn_permlane32_swap(__float_as_uint(rm),__float_as_uint(rm),false,false); rm=__builtin_fmaxf(__uint_as_float(rr[0]),__uint_as_float(rr[1])); } \
      resc=false; \
      if(__builtin_expect(__any(rm>(float)THRL),0)){ const float dl=__builtin_fmaxf(rm,0.f); mhat+=dl; cbase=cq_l-mhat; \
        _Pragma("unroll") for(int r=0;r<16;++r){C0[r]-=dl;C1[r]-=dl;} \
        const float f=__builtin_amdgcn_exp2f(-dl); l_reg*=f; if(hi==0)wsf[r32]=f; resc=true; } } \
    SBAR(); \
    GAPB(o[0]=__builtin_amdgcn_mfma_f32_32x32x16_bf16(PAF(0),VFR(0),o[0],0,0,0), C0,0); \
    GAPB(o[1]=__builtin_amdgcn_mfma_f32_32x32x16_bf16(PAF(0),VFR(4),o[1],0,0,0), C0,4); \
    KRD(GL,0); GAPB(o[0]=__builtin_amdgcn_mfma_f32_32x32x16_bf16(PAF(1),VFR(1),o[0],0,0,0), C0,8); \
    KRD(GL,1); GAPB(o[1]=__builtin_amdgcn_mfma_f32_32x32x16_bf16(PAF(1),VFR(5),o[1],0,0,0), C0,12); \
    KRD(GL,2); GAPB(o[0]=__builtin_amdgcn_mfma_f32_32x32x16_bf16(PAF(2),VFR(2),o[0],0,0,0), C1,0); \
    KRD(GL,3); GAPB(o[1]=__builtin_amdgcn_mfma_f32_32x32x16_bf16(PAF(2),VFR(6),o[1],0,0,0), C1,4); \
    GAPB(o[0]=__builtin_amdgcn_mfma_f32_32x32x16_bf16(PAF(3),VFR(3),o[0],0,0,0), C1,8); \
    GAPB(o[1]=__builtin_amdgcn_mfma_f32_32x32x16_bf16(PAF(3),VFR(7),o[1],0,0,0), C1,12); \
    }while(0)
  int t=1;
  #undef CMASK
  #define CMASK(P0,P1,t) do{}while(0)
  for(;t+5<NT;t+=2){
    STEP(pB0,pB1,pA0,pA1,t,true,true,true);     WAIT_BAR(2); RESC(); ROT();
    STEP(pA0,pA1,pB0,pB1,t+1,true,true,true);   WAIT_BAR(2); RESC(); ROT();
  }
  #undef CMASK
  #define CMASK(P0,P1,t) do{int jb_=(t)-(NT-4); if(jb_>=0)cmask(P0,P1,jb_,qrel,hi);}while(0)
  #define ENDW(tt) do{ if((tt)+3<NT){WAIT_BAR(2);} else if((tt)+2<NT){WAIT_BAR(1);} else {WAIT_BAR(0);} }while(0)
  for(;t+1<NT;t+=2){
    STEP(pB0,pB1,pA0,pA1,t,(t+3<NT),(t+1<NT),(t+1<NT));       ENDW(t);   RESC(); ROT();
    STEP(pA0,pA1,pB0,pB1,t+1,(t+4<NT),(t+2<NT),(t+2<NT));     ENDW(t+1); RESC(); ROT();
  }
  STEP(pB0,pB1,pA0,pA1,NT-1,false,false,false); RESC();
  { float sacc=pB0[0]+pB0[1]; _Pragma("unroll") for(int r=2;r<16;++r)sacc+=pB0[r]; _Pragma("unroll") for(int r=0;r<16;++r)sacc+=pB1[r]; l_reg+=sacc;
    pw0=(u32x4){PKW(pB0,0),PKW(pB0,2),PKW(pB0,4),PKW(pB0,6)};pw1=(u32x4){PKW(pB0,8),PKW(pB0,10),PKW(pB0,12),PKW(pB0,14)};pw2=(u32x4){PKW(pB1,0),PKW(pB1,2),PKW(pB1,4),PKW(pB1,6)};pw3=(u32x4){PKW(pB1,8),PKW(pB1,10),PKW(pB1,12),PKW(pB1,14)};
    SBAR(); pv(o,vb0+sl_cur,PAF(0),PAF(1),PAF(2),PAF(3)); }
  #undef PKW
  #undef PAF
  #undef VFR
  #undef PIN
  #undef MX3
  #undef GAPA
  #undef GAPB
  #undef EX
  #undef VRD
  #undef KRD
  #undef CKL
  #undef CKS
  #undef STEP
  #undef ENDW
  {auto rr=__builtin_amdgcn_permlane32_swap(__float_as_uint(l_reg),__float_as_uint(l_reg),false,false);l_reg=__uint_as_float(rr[0])+__uint_as_float(rr[1]);}
  if(hi==0)wsf[32+r32]=l_reg;asm volatile("s_waitcnt lgkmcnt(0)":::"memory");
  float rli[16];
  #pragma unroll
  for(int r=0;r<16;++r)rli[r]=__builtin_amdgcn_rcpf(wsf[32+crow(r,hi)]);
  unsigned char*Ow=Oh+(rowbase+q0+wid*QBLK)*OPITCH;
  { bf16*stg=(bf16*)(shm+LDS_OST)+wid*2048;
    #pragma unroll
    for(int r=0;r<16;++r){const int orow=crow(r,hi);
      #pragma unroll
      for(int d0=0;d0<2;++d0)stg[orow*64+d0*32+r32]=__float2bfloat16(o[d0][r]*rli[r]);}
    asm volatile("s_waitcnt lgkmcnt(0)":::"memory");
    #pragma unroll
    for(int i=0;i<4;++i){const int row=i*8+(lane>>3),ch=lane&7; const u32x4 v=*(const u32x4*)(stg+row*64+ch*8); ATTN_STORE8(Ow+(long)row*OPITCH+ch*8,v);} }
  asm volatile("s_waitcnt lgkmcnt(0)\n\ts_barrier":::"memory");
  #undef DMA_K
  #undef DMA_V
  #undef CMASK
  #undef CINIT
  #undef CKG
  #undef START
  #undef RESC
  #undef ROT
}

__device__ __forceinline__ void sb_unit(int b,int qb,const bf16*Qh,const bf16*__restrict__ Kh_,const bf16*__restrict__ Vh_,unsigned char*Oh,char*shm,const int tid_in){
  int tid=tid_in;
  asm volatile("":"+s"(Qh),"+s"(Kh_),"+s"(Vh_),"+s"(Oh),"+v"(tid));
  const int lane=tid&63,r32=lane&31,hi=lane>>5; const int wid=__builtin_amdgcn_readfirstlane(tid>>6);
  const long rowbase=(long)b*SEQ; const int q0=qb*QB;
  const bf16*Qw=Qh+(rowbase+q0+wid*QBLK)*DM;
  const bf16*Kh=Kh_+rowbase*DM,*Vh=Vh_+rowbase*DM;
  const unsigned lds0=(unsigned)(uintptr_t)shm;
  const lds_cptr shm3=(lds_cptr)shm;
  const bf16*ksrc=Kh+(long)lane*DM+wid*8;
  const bf16*vsrc=Vh+(long)(16*(wid&3)+(lane>>2))*DM+(wid>>2)*32+(lane&3)*8;
  const unsigned kdst=lds0+LDS_K+wid*1024, vdst=lds0+LDS_V+wid*1024;
  #define DMA_K(t,slot) glds16(ksrc+(long)(t)*KVBLK*DM,(unsigned)__builtin_amdgcn_readfirstlane(kdst+(slot)))
  #define DMA_V(t,slot) glds16(vsrc+(long)(t)*KVBLK*DM,(unsigned)__builtin_amdgcn_readfirstlane(vdst+(slot)))
  const int vb0=(int)(lds0+LDS_V)+((lane>>4)&1)*32+(lane&3)*8+(4*hi+((lane&15)>>2))*64;
  const lds_cptr kp0=shm3+LDS_K+hi*1024+r32*16;
  const int NT=(q0+QB)/KVBLK;
  DMA_K(NT-1,0);DMA_V(NT-1,0);
  bf16x8 qr[4];
  #pragma unroll
  for(int d0=0;d0<4;++d0)qr[d0]=*(const __attribute__((address_space(1))) bf16x8*)(&Qw[(long)r32*DM+d0*16+hi*8]);
  f32x16 o[2];o[0]=f32x16{};o[1]=f32x16{};
  float one=1.0f; asm volatile("":"+v"(one));
  float R=one;
  const int qrel=wid*QBLK+r32;
  constexpr float SB_DONE=1.0995116e12f;
  __attribute__((address_space(3))) unsigned* dflag=(__attribute__((address_space(3))) unsigned*)(shm3+LDS_WS);
  for(int it=0;it<NT;++it){
    const int t=NT-1-it; const int slot=(it&1)*SLOTB;
    if(lane==0) dflag[(it&1)*NW+wid]=__all(R>SB_DONE)?1u:0u;
    asm volatile("s_waitcnt vmcnt(0) lgkmcnt(0)\n\ts_barrier":::"memory");
    { const u32x4 f0=*(const __attribute__((address_space(3))) u32x4*)(dflag+(it&1)*NW), f1=*(const __attribute__((address_space(3))) u32x4*)(dflag+(it&1)*NW+4);
      if((f0.x&f0.y&f0.z&f0.w&f1.x&f1.y&f1.z&f1.w)!=0u) break; }
    if(it+1<NT){ DMA_K(t-1,slot^SLOTB); DMA_V(t-1,slot^SLOTB); }
    if(it<4 && 64*(3-it)>wid*QBLK+QBLK-1) continue;
    bf16x8 kf[8]; kload8(kf,kp0+slot);
    f32x16 p0=f32x16{},p1=f32x16{};
    #pragma unroll
    for(int d0=0;d0<4;++d0){ p0=__builtin_amdgcn_mfma_f32_32x32x16_bf16(kf[2*d0],qr[d0],p0,0,0,0); p1=__builtin_amdgcn_mfma_f32_32x32x16_bf16(kf[2*d0+1],qr[d0],p1,0,0,0); }
    if(it<4) cmask_strict(p0,p1,3-it,qrel,hi);
    #pragma unroll
    for(int r=0;r<16;++r){ p0[r]=__builtin_amdgcn_exp2f(p0[r]); p1[r]=__builtin_amdgcn_exp2f(p1[r]); }
    float c=R;
    #pragma unroll
    for(int g=7;g>=0;--g){
      float u0,u1,u2,u3;
      if(g<4){u0=p0[4*g];u1=p0[4*g+1];u2=p0[4*g+2];u3=p0[4*g+3];}else{u0=p1[4*(g-4)];u1=p1[4*(g-4)+1];u2=p1[4*(g-4)+2];u3=p1[4*(g-4)+3];}
      const float s3=one+u3, s2=(one+u2)*s3, s1=(one+u1)*s2, s0=(one+u0)*s1;
      const unsigned s0b=__float_as_uint(s0);
      auto rr=__builtin_amdgcn_permlane32_swap(s0b,s0b,false,false);
      const float gpartner=__uint_as_float(rr[0]==s0b?rr[1]:rr[0]);
      const float carry=hi?c:c*gpartner;
      const float a0=u0*__builtin_amdgcn_rcpf(s0*carry), a1=u1*__builtin_amdgcn_rcpf(s1*carry), a2=u2*__builtin_amdgcn_rcpf(s2*carry), a3=u3*__builtin_amdgcn_rcpf(s3*carry);
      if(g<4){p0[4*g]=a0;p0[4*g+1]=a1;p0[4*g+2]=a2;p0[4*g+3]=a3;}else{p1[4*(g-4)]=a0;p1[4*(g-4)+1]=a1;p1[4*(g-4)+2]=a2;p1[4*(g-4)+3]=a3;}
      c=c*(s0*gpartner);
    }
    R=c;
    u32x4 pw0,pw1,pw2,pw3;
    #define PKW(P,B) cvtpk_s(P[B],P[B+1])
    pw0=(u32x4){PKW(p0,0),PKW(p0,2),PKW(p0,4),PKW(p0,6)};pw1=(u32x4){PKW(p0,8),PKW(p0,10),PKW(p0,12),PKW(p0,14)};pw2=(u32x4){PKW(p1,0),PKW(p1,2),PKW(p1,4),PKW(p1,6)};pw3=(u32x4){PKW(p1,8),PKW(p1,10),PKW(p1,12),PKW(p1,14)};
    #undef PKW
    pv(o,vb0+slot,__builtin_bit_cast(bf16x8,pw0),__builtin_bit_cast(bf16x8,pw1),__builtin_bit_cast(bf16x8,pw2),__builtin_bit_cast(bf16x8,pw3));
  }
  unsigned char*Ow=Oh+(rowbase+q0+wid*QBLK)*OPITCH;
  { bf16*stg=(bf16*)(shm+LDS_OST)+wid*2048;
    #pragma unroll
    for(int r=0;r<16;++r){const int orow=crow(r,hi);
      #pragma unroll
      for(int d0=0;d0<2;++d0)stg[orow*64+d0*32+r32]=__float2bfloat16(o[d0][r]);}
    asm volatile("s_waitcnt lgkmcnt(0)":::"memory");
    #pragma unroll
    for(int i=0;i<4;++i){const int row=i*8+(lane>>3),ch=lane&7; const u32x4 v=*(const u32x4*)(stg+row*64+ch*8); ATTN_STORE8(Ow+(long)row*OPITCH+ch*8,v);} }
  asm volatile("s_waitcnt vmcnt(0) lgkmcnt(0)\n\ts_barrier":::"memory");
  #undef DMA_K
  #undef DMA_V
}
#undef SBAR
#undef WAIT_BAR
}
#ifndef MK_IN_FP8
#define MK_IN_FP8 1
#endif
#ifndef MK_GU_FP8
#define MK_GU_FP8 1
#endif
#ifndef MK_PER_PHASE
#define MK_PER_PHASE 0
#endif
constexpr int NWAVES = 8, NTHR = NWAVES * 64;
constexpr int BATCH = 4, SEQ = 4096, T = BATCH * SEQ, D = 2048, DEPTH = 2, D6 = 6 * D;
constexpr int MIXC = 5648;
constexpr int NPROJ = 5632, NPROJ_PAD = 5888;
constexpr int C_QSB = 0, C_KSB = 512, C_VSB = 1024, C_QFX = 1536, C_KFX = 2560, C_VFX = 3584, C_GA = 4608, C_GG = 5120;
constexpr int O_SB = 0, O_FX = 512, O_CV = 1536;
constexpr int NEXP = 32, DEXP = 1024, NFH = 16, CONVW = 31, CCH = 512;
constexpr int LISTCAP = 16384, HIDROWS = 2 * T + NEXP * 256;
constexpr float LN_EPS = 1e-5f, ALPHA = 1.4142135623730951f, LOG2E = 1.4426950408889634f;
constexpr int NPHASE = 2 + 8 * DEPTH;

constexpr size_t MiB = 1u << 20;
constexpr size_t WS_CTL = 0, CTL_ZERO_BYTES = 1 * MiB;
constexpr size_t WS_MOD = 1 * MiB, WS_RWT = 2 * MiB, WS_FLOG = 3 * MiB, WS_CUM = 4 * MiB, WS_ROUTE = 5 * MiB, WS_LIST = 6 * MiB;
constexpr size_t WS_WIN = 8 * MiB, WS_WOUT = 54 * MiB, WS_WGU = 70 * MiB, WS_WDN = 582 * MiB;
constexpr size_t WS_H = 838 * MiB, WS_PROJ = 902 * MiB, WS_MIX = 1078 * MiB, WS_Z = 1142 * MiB, WS_X1 = 1270 * MiB, WS_X2 = 1398 * MiB, WS_HID = 1526 * MiB, WS_Y = 1606 * MiB, WS_END = 1766 * MiB;
constexpr size_t WS_H8 = WS_Z + 64 * MiB;
static_assert(WS_WIN + (size_t)DEPTH * NPROJ_PAD * D * 2 <= WS_WOUT && WS_WOUT + (size_t)DEPTH * D * D * 2 <= WS_WGU && WS_WGU + (size_t)DEPTH * NEXP * 2048 * 2048 * 2 <= WS_WDN && WS_WDN + (size_t)DEPTH * NEXP * 2048 * 1024 * 2 <= WS_H, "ws map (weights)");
static_assert(WS_H + (size_t)T * D * 2 <= WS_PROJ && WS_PROJ + (size_t)T * NPROJ * 2 <= WS_MIX && WS_MIX + (size_t)T * D * 2 <= WS_Z && WS_Z + (size_t)T * D * 4 <= WS_X1 && WS_X1 + (size_t)T * D * 4 <= WS_X2 && WS_X2 + (size_t)T * D * 4 <= WS_HID, "ws map (act)");
static_assert(WS_HID + (size_t)HIDROWS * DEXP * 2 <= WS_Y && WS_Y + (size_t)HIDROWS * D * 2 <= WS_END, "ws map (moe)");
constexpr int CW_TMO = 0, CW_CODE = 1, CW_BAR = 4096, CW_CNT = 8192, CW_Q = 12288, CW_XC = 12288 + 4 * 64;

constexpr int RING_OFF = 0, RING_BYTES = 131072;
constexpr int LDSCTL_OFF = 8 * 128 * 33 * 4  , MISC_OFF = LDSCTL_OFF + 320, MOE_OFF = LDSCTL_OFF + 1024;
constexpr int LDS_BYTES = 147456;

#define GAS __attribute__((address_space(1)))
#define LAS __attribute__((address_space(3)))
typedef unsigned short bf16;
typedef unsigned v4u __attribute__((ext_vector_type(4)));
typedef unsigned v2u __attribute__((ext_vector_type(2)));
typedef float f32x4 __attribute__((ext_vector_type(4)));
typedef float f32x2 __attribute__((ext_vector_type(2)));
typedef short bf16x8 __attribute__((ext_vector_type(8)));
typedef GAS unsigned gu32;
#define RLX_AGENT __ATOMIC_RELAXED, __HIP_MEMORY_SCOPE_AGENT
#define LDS_WAIT() asm volatile("s_waitcnt lgkmcnt(0)" ::: "memory")
#define VM_WAIT() asm volatile("s_waitcnt vmcnt(0)" ::: "memory")
__device__ __forceinline__ unsigned f2bf(float f) { unsigned u = __builtin_bit_cast(unsigned, f); return (u + 0x7fffu + ((u >> 16) & 1u)) >> 16; }
__device__ __forceinline__ unsigned pk2(float lo, float hi) { return f2bf(lo) | (f2bf(hi) << 16); }
__device__ __forceinline__ float bf2f(unsigned short b) { return __uint_as_float(((unsigned)b) << 16); }
__device__ __forceinline__ float clamp_fp8(float x) { return __builtin_amdgcn_fmed3f(x, -448.f, 448.f); }
__device__ __forceinline__ unsigned pk4_fp8(float a, float b, float c, float d) { int p = __float_as_int(a)  ; p = __builtin_amdgcn_cvt_pk_fp8_f32(a, b, p, false); p = __builtin_amdgcn_cvt_pk_fp8_f32(c, d, p, true); return (unsigned)p; }
constexpr float S_W8 = 64.f, S_A8 = 4.f;
constexpr int SC_W8 = 127 - 4, SC_A8 = 127 - 4;

#define XB_TMO      128
#define XB_XCNT(j)  (256  + 64 * (j))
#define XB_XSUB(j)  (1280 + 64 * (j))
#define XB_XGEN(j)  (2304 + 64 * (j))
#define XB_TOP      3328
#define XB_TOPGEN   3392
#define XCD_BAR_WORDS 3456
#define XB_SPIN_CAP (1u << 18)
__device__ __forceinline__ unsigned xb_ld(gu32* p)              { return __hip_atomic_load(p, __ATOMIC_RELAXED, __HIP_MEMORY_SCOPE_AGENT); }
__device__ __forceinline__ unsigned xb_add(gu32* p, unsigned v) { return __hip_atomic_fetch_add(p, v, __ATOMIC_RELAXED, __HIP_MEMORY_SCOPE_AGENT); }
__device__ __forceinline__ unsigned xb_xcc_id() { return (unsigned)__builtin_amdgcn_s_getreg((3 << 11) | 20) & 0xFu; }
#define XB_SPIN(cond, bar) do { unsigned _sp = 0; while (cond) { __builtin_amdgcn_s_sleep(1); \
    if ((++_sp & 255u) == 0u) { if (xb_ld(&(bar)[XB_TMO])) break; if (_sp > XB_SPIN_CAP) { (void)xb_add(&(bar)[XB_TMO], 1u); break; } } } } while (0)
struct XcdBarrier { gu32* bar; unsigned x; volatile LAS unsigned* st; };
__device__ __forceinline__ XcdBarrier xcd_barrier_post(gu32* bar, volatile LAS unsigned* st, bool leader) {
    XcdBarrier b; b.bar = bar; b.x = xb_xcc_id(); b.st = st;
    if (leader) (void)xb_add(&bar[XB_XCNT(b.x)], 1u);
    return b;
}
__device__ __forceinline__ void xcd_barrier_complete(gu32* bar, unsigned x, unsigned& nloc, unsigned& nx) {
    const unsigned G = gridDim.x * gridDim.y * gridDim.z;
    unsigned sum, cnt, mine, sp = 0u;
    for (;;) {
        sum = 0u; cnt = 0u; mine = 0u;
#pragma unroll 1
        for (unsigned j = 0; j < 16; ++j) { const unsigned c = xb_ld(&bar[XB_XCNT(j)]); sum += c; cnt += (c > 0u) ? 1u : 0u; mine = (j == x) ? c : mine; }
        if (sum == G) break;
        __builtin_amdgcn_s_sleep(1);
        if ((++sp & 255u) == 0u) { if (xb_ld(&bar[XB_TMO])) break; if (sp > XB_SPIN_CAP) { (void)xb_add(&bar[XB_TMO], 1u); break; } }
    }
    nloc = mine > 0u ? mine : 1u; nx = cnt > 0u ? cnt : 1u;
}
__device__ __forceinline__ void xcd_barrier(const XcdBarrier& b, const bool leader) {
    asm volatile("s_waitcnt vmcnt(0)" ::: "memory");
    __syncthreads();
    if (leader) {
        gu32* bar = b.bar;
        __builtin_amdgcn_s_waitcnt(0);
        unsigned nloc = b.st[0], nx = b.st[1];
        if (nloc == 0u) { xcd_barrier_complete(bar, b.x, nloc, nx); b.st[0] = nloc; b.st[1] = nx; }
        const unsigned old = xb_add(&bar[XB_XSUB(b.x)], 1u);
        const unsigned gen = old / nloc;
        if (old + 1u == (gen + 1u) * nloc) {
            __builtin_amdgcn_fence(__ATOMIC_RELEASE, "agent");
            asm volatile("s_waitcnt vmcnt(0)" ::: "memory");
            const unsigned og = xb_add(&bar[XB_TOP], 1u);
            const unsigned tg = og / nx;
            if (og + 1u == (tg + 1u) * nx) xb_add(&bar[XB_TOPGEN], 1u);
            else XB_SPIN(xb_ld(&bar[XB_TOPGEN]) == tg, bar);
            __builtin_amdgcn_fence(__ATOMIC_ACQUIRE, "agent");
            xb_add(&bar[XB_XGEN(b.x)], 1u);
            asm volatile("s_waitcnt vmcnt(0)" ::: "memory");
        } else {
            XB_SPIN(xb_ld(&bar[XB_XGEN(b.x)]) == gen, bar);
            __builtin_amdgcn_fence(__ATOMIC_ACQUIRE, "agent");
            asm volatile("s_waitcnt vmcnt(0)" ::: "memory");
        }
    }
    __syncthreads();
}

struct Args {
    const float *x, *c, *ada_w, *ada_b, *w_in, *b_forget, *conv_w, *conv_b, *conv_ln_g, *conv_ln_b, *w_out, *ln1_g, *ln1_b, *r1_w, *r1_b, *r2_w, *r2_b, *w_gate, *w_up, *w_down, *ln2_g, *ln2_b;
    float* out; unsigned char* ws; int ph_lo, ph_hi, dup, pad;
};
typedef const __attribute__((address_space(4))) Args* ArgsP;
__device__ __forceinline__ ArgsP kargs() { ArgsP p = (ArgsP)__builtin_amdgcn_kernarg_segment_ptr(); asm volatile("" : "+s"(p)); return p; }

#define dpp_f(v, ctrl) __int_as_float(__builtin_amdgcn_update_dpp(0, __float_as_int(v), (ctrl), 0xF, 0xF, false))
__device__ __forceinline__ float wave_sum(float v) {
    v += dpp_f(v, 0xB1); v += dpp_f(v, 0x4E); v += dpp_f(v, 0x141); v += dpp_f(v, 0x140);
    const float r0 = __int_as_float(__builtin_amdgcn_readlane(__float_as_int(v), 0)), r1 = __int_as_float(__builtin_amdgcn_readlane(__float_as_int(v), 16));
    const float r2 = __int_as_float(__builtin_amdgcn_readlane(__float_as_int(v), 32)), r3 = __int_as_float(__builtin_amdgcn_readlane(__float_as_int(v), 48));
    return (r0 + r1) + (r2 + r3);
}
__device__ __forceinline__ float silu_f(float v) { return v / (1.0f + __expf(-v)); }

#define LDS_BARRIER() do { asm volatile("s_waitcnt lgkmcnt(0)" ::: "memory"); __builtin_amdgcn_s_barrier(); asm volatile("" ::: "memory"); } while (0)
struct TItem { const float* W; unsigned char* WT; int ldw, k0, n0, ldk, dst_row0, rstride, f8; };
__device__ __forceinline__ TItem titem_decode(ArgsP A, int it) {
    constexpr int I_A = 16 * 18, I_B = 16 * 4, I_O = 16 * 8;
    constexpr int PER_L = I_A + I_B + I_O;
    unsigned char* ws = A->ws; TItem t; const int l = it / PER_L; int r = it % PER_L; t.rstride = 1; t.f8 = 0;
    if (r < I_A + I_B) { t.W = A->w_in + (size_t)l * D * MIXC; t.ldw = MIXC; t.WT = ws + WS_WIN + (size_t)l * NPROJ_PAD * D * (MK_IN_FP8 ? 1 : 2); t.ldk = D; t.f8 = MK_IN_FP8;
        if (r < I_A) { const int kb = r / 18, nb = r % 18; t.k0 = 128 * kb; t.n0 = 256 * nb; t.dst_row0 = 256 * nb; }
        else { r -= I_A; const int kb = r / 4, nb = r % 4; t.k0 = 128 * kb; t.n0 = 4624 + 256 * nb; t.dst_row0 = 4608 + 256 * nb; }
        return t; }
    r -= I_A + I_B;
    { const int kb = r / 8, nb = r % 8; t.W = A->w_out + (size_t)l * D * D; t.ldw = D; t.WT = ws + WS_WOUT + (size_t)l * D * D; t.ldk = D; t.k0 = 128 * kb; t.n0 = 256 * nb; t.dst_row0 = 256 * nb; t.f8 = 1; return t; }
}
constexpr int N_XTILE = 3 * NEXP * 64;
__device__ __forceinline__ TItem titem_decode_expert(ArgsP A, int l, int r) {
    constexpr int I_G = NEXP * 64, I_U = NEXP * 64;
    unsigned char* ws = A->ws; TItem t; t.rstride = 1; t.f8 = 1;
    if (r < I_G + I_U) { const int up = r >= I_G; if (up) r -= I_G; const int e = r / 64, q = r % 64, kb = q / 4, nb = q % 4;
        t.W = (up ? A->w_up : A->w_gate) + ((size_t)l * NEXP + e) * D * DEXP; t.ldw = DEXP; t.WT = ws + WS_WGU + ((size_t)l * NEXP + e) * 2048 * 2048 * (MK_GU_FP8 ? 1 : 2); t.ldk = D;
        t.k0 = 128 * kb; t.n0 = 256 * nb; t.dst_row0 = 512 * nb + up; t.rstride = 2; t.f8 = MK_GU_FP8; return t; }
    r -= I_G + I_U;
    { const int e = r / 64, q = r % 64, kb = q / 8, nb = q % 8; t.W = A->w_down + ((size_t)l * NEXP + e) * DEXP * D; t.ldw = D; t.WT = ws + WS_WDN + ((size_t)l * NEXP + e) * 2048 * 1024; t.ldk = DEXP;
      t.k0 = 128 * kb; t.n0 = 256 * nb; t.dst_row0 = 256 * nb; return t; }
}
static_assert(MK_IN_FP8 && MK_GU_FP8, "the register-transposing weight copy writes fp8 rows only");
__device__ __forceinline__ void titem_load(const TItem& t, f32x4 (&v)[16], int lane, int wave) {
    const float* p = t.W + (size_t)(t.k0 + 16 * (lane >> 3)) * t.ldw + t.n0 + 32 * wave + 4 * (lane & 7); const size_t st = (size_t)t.ldw;
#pragma unroll
    for (int i = 0; i < 16; ++i) v[i] = __builtin_nontemporal_load((const GAS f32x4*)(p + i * st));
}
__device__ __forceinline__ void titem_store(const TItem& t, const f32x4 (&v)[16], LAS float*, int lane, int wave) {
    unsigned char* op = t.WT + (size_t)(t.dst_row0 + (32 * wave + 4 * (lane & 7)) * t.rstride) * t.ldk + t.k0 + 16 * (lane >> 3); const size_t ost = (size_t)t.rstride * t.ldk;
#pragma unroll
    for (int c = 0; c < 4; ++c) { v4u o;
        o.x = pk4_fp8(v[0][c] * S_W8, v[1][c] * S_W8, v[2][c] * S_W8, v[3][c] * S_W8); o.y = pk4_fp8(v[4][c] * S_W8, v[5][c] * S_W8, v[6][c] * S_W8, v[7][c] * S_W8);
        o.z = pk4_fp8(v[8][c] * S_W8, v[9][c] * S_W8, v[10][c] * S_W8, v[11][c] * S_W8); o.w = pk4_fp8(v[12][c] * S_W8, v[13][c] * S_W8, v[14][c] * S_W8, v[15][c] * S_W8);
        __builtin_nontemporal_store(o, (GAS v4u*)(op + c * ost)); }
}
__device__ __forceinline__ void convert_claim(ArgsP A, int l, int n, LAS unsigned char* lds, int tid, int wave) {
    LAS unsigned* xw = (LAS unsigned*)(lds + MISC_OFF + 96);
    if (tid == 0) *xw = __hip_atomic_fetch_add((gu32*)(A->ws + WS_CTL) + CW_XC + l * 64, (unsigned)n, RLX_AGENT);
    __syncthreads();
    const int x0 = __builtin_amdgcn_readfirstlane((int)*xw);
    __syncthreads();
#pragma unroll 1
    for (int j = 0; j < n; ++j) { if (x0 + j >= N_XTILE) break;
        int l2; asm volatile("v_mbcnt_lo_u32_b32 %0, -1, 0\n\tv_mbcnt_hi_u32_b32 %0, -1, %0" : "=v"(l2));
        const TItem t = titem_decode_expert(A, l, x0 + j); f32x4 v[16]; titem_load(t, v, l2, wave); titem_store(t, v, (LAS float*)(lds + RING_OFF), l2, wave); }
}
__device__ __forceinline__ void p0_prologue(ArgsP A, LAS unsigned char* lds, int vcu, int G, int tid, int lane, int wave) {
    unsigned char* ws = A->ws;
    {
        LAS float* sT = (LAS float*)(lds + RING_OFF);
        LAS float* red = (LAS float*)(lds + RING_OFF + 32768);
        for (int i = tid; i < BATCH * D; i += NTHR) { const int b = i / D, k = i % D; sT[k * 4 + b] = silu_f(A->c[i]); }
        __syncthreads();
        float* mod = (float*)(ws + WS_MOD);
        for (int it = vcu; it < 256; it += G) {
            const int l = it / 128, col0 = (it % 128) * 96;
            float acc[8];
#pragma unroll
            for (int j = 0; j < 8; ++j) acc[j] = 0.f;
            if (lane < 48) {
                const float* wp = A->ada_w + ((size_t)l * D + wave * 256) * D6 + col0 + 2 * lane;
                f32x2 wa[8], wb[8];
#define MG_LOAD(W, g) do { const int g_ = (g) < 32 ? (g) : 31; _Pragma("unroll") for (int i = 0; i < 8; ++i) W[i] = __builtin_nontemporal_load((const GAS f32x2*)(wp + (size_t)(8 * g_ + i) * D6)); } while (0)
#define MG_FMA(W, g) do { _Pragma("unroll") for (int i = 0; i < 8; ++i) { const f32x2 w = W[i]; const f32x4 s = *(const LAS f32x4*)(sT + (wave * 256 + 8 * (g) + i) * 4); \
                    acc[0] += s.x * w.x; acc[1] += s.x * w.y; acc[2] += s.y * w.x; acc[3] += s.y * w.y; acc[4] += s.z * w.x; acc[5] += s.z * w.y; acc[6] += s.w * w.x; acc[7] += s.w * w.y; } } while (0)
                MG_LOAD(wa, 0);
#pragma unroll 1
                for (int g = 0; g < 32; g += 2) { MG_LOAD(wb, g + 1); MG_FMA(wa, g); MG_LOAD(wa, g + 2); MG_FMA(wb, g + 1); }
#undef MG_LOAD
#undef MG_FMA
#pragma unroll
                for (int j = 0; j < 8; ++j) red[(wave * 48 + lane) * 8 + j] = acc[j];
            }
            __syncthreads();
            if (tid < 384) { const int b = tid / 96, cc = tid % 96, ln = cc >> 1, comp = cc & 1; float s = 0.f;
#pragma unroll
                for (int w = 0; w < 8; ++w) s += red[(w * 48 + ln) * 8 + b * 2 + comp];
                mod[((size_t)l * BATCH + b) * D6 + col0 + cc] = s + A->ada_b[(size_t)l * D6 + col0 + cc]; }
            __syncthreads();
        }
    }
    {
        LAS float* scr = (LAS float*)(lds + RING_OFF);
        constexpr int NITEM = DEPTH * (16 * 18 + 16 * 4 + 16 * 8);
        int it = vcu;
        if (it < NITEM) { TItem cur = titem_decode(A, it); f32x4 va[16], vb[16]; titem_load(cur, va, lane, wave);
#pragma unroll 1
            for (;;) {
                const int itn = it + G; const bool hn = itn < NITEM; TItem nx = cur; if (hn) { nx = titem_decode(A, itn); titem_load(nx, vb, lane, wave); }
                titem_store(cur, va, scr, lane, wave);
                if (!hn) break;
                const int itn2 = itn + G; const bool hn2 = itn2 < NITEM; if (hn2) { cur = titem_decode(A, itn2); titem_load(cur, va, lane, wave); }
                titem_store(nx, vb, scr, lane, wave);
                if (!hn2) break;
                it = itn2;
            } }
        for (int i = vcu * NTHR + tid; i < DEPTH * 16 * D; i += G * NTHR) { const int l = i / (16 * D), k = (i / 16) % D, n = i % 16;
            const float w = A->w_in[((size_t)l * D + k) * MIXC + 4608 + n];
            if (MK_IN_FP8) (ws + WS_WIN)[((size_t)l * NPROJ_PAD + NPROJ + n) * D + k] = (unsigned char)(pk4_fp8(w * S_W8, 0.f, 0.f, 0.f) & 0xffu);
            else ((bf16*)(ws + WS_WIN))[((size_t)l * NPROJ_PAD + NPROJ + n) * D + k] = (bf16)f2bf(w); }
        bf16* rwt = (bf16*)(ws + WS_RWT);
        for (int i = vcu * NTHR + tid; i < DEPTH * 48 * D; i += G * NTHR) {
            const int l = i / (48 * D), n = (i / D) % 48, k = i % D; float w = 0.f;
            if (n < 4) w = A->r1_w[((size_t)l * D + k) * 4 + n]; else if (n < 36) { const int g = (n - 4) >> 3, e = (n - 4) & 7; w = A->r2_w[(((size_t)l * 4 + g) * D + k) * 8 + e]; }
            const unsigned hi = f2bf(w); const float rem = w - __uint_as_float(hi << 16);
            rwt[((size_t)l * 96 + n) * D + k] = (bf16)hi; rwt[((size_t)l * 96 + 48 + n) * D + k] = (bf16)f2bf(rem);
        }
    }
}

__device__ __forceinline__ void row_stats(const f32x4 (&v)[8], float& mean, float& rstd) {
    float s = 0.f;
#pragma unroll
    for (int j = 0; j < 8; ++j) s += (v[j].x + v[j].y) + (v[j].z + v[j].w);
    mean = wave_sum(s) * (1.f / D); float s2 = 0.f;
#pragma unroll
    for (int j = 0; j < 8; ++j) { const f32x4 d = v[j] - mean; s2 += (d.x * d.x + d.y * d.y) + (d.z * d.z + d.w * d.w); }
    rstd = 1.f / sqrtf(wave_sum(s2) * (1.f / D) + LN_EPS);
}
__device__ __forceinline__ void ld_row16(const bf16* row, int lane, v2u (&r)[8]) {
#pragma unroll
    for (int j = 0; j < 8; ++j) r[j] = *((const GAS v2u*)row + lane + 64 * j);
}
__device__ __forceinline__ void ld_row32(const float* row, int lane, f32x4 (&r)[8]) {
#pragma unroll
    for (int j = 0; j < 8; ++j) r[j] = *((const GAS f32x4*)row + lane + 64 * j);
}
__device__ __forceinline__ f32x4 bf4(const v2u a) { f32x4 o; o.x = __uint_as_float(a.x << 16); o.y = __uint_as_float(a.x & 0xffff0000u); o.z = __uint_as_float(a.y << 16); o.w = __uint_as_float(a.y & 0xffff0000u); return o; }
__device__ __forceinline__ void st_row16(bf16* row, int lane, const f32x4 (&v)[8]) {
    GAS v2u* o8 = (GAS v2u*)row + lane;
#pragma unroll
    for (int j = 0; j < 8; ++j) { v2u w; w.x = pk2(v[j].x, v[j].y); w.y = pk2(v[j].z, v[j].w); o8[64 * j] = w; }
}
__device__ __forceinline__ void ln_mod_store(const f32x4 (&v)[8], const LAS float* sc, const LAS float* sh, bf16* orow, int lane, unsigned char* o8row = nullptr) {
    float mean, rstd; row_stats(v, mean, rstd);
    GAS v2u* o8 = (GAS v2u*)orow + lane; GAS unsigned* q8 = (GAS unsigned*)o8row + lane;
#pragma unroll
    for (int j = 0; j < 8; ++j) { const f32x4 s = *((const LAS f32x4*)sc + lane + 64 * j), b = *((const LAS f32x4*)sh + lane + 64 * j);
        const f32x4 h = (v[j] - mean) * rstd * (1.0f + s) + b; if (orow) { v2u w; w.x = pk2(h.x, h.y); w.y = pk2(h.z, h.w); o8[64 * j] = w; }
        if (o8row) q8[64 * j] = pk4_fp8(clamp_fp8(h.x * S_A8), clamp_fp8(h.y * S_A8), clamp_fp8(h.z * S_A8), clamp_fp8(h.w * S_A8)); }
}
template <int N> __device__ __forceinline__ void stage_vecs(LAS float* dst, const float* const (&src)[N], int tid) {
    asm volatile("" : "+v"(tid)); const unsigned off = (unsigned)tid * 16u; f32x4 v[N];
#pragma unroll
    for (int k = 0; k < N; ++k) v[k] = *(const GAS f32x4*)((const GAS char*)src[k] + off);
#pragma unroll
    for (int k = 0; k < N; ++k) ((LAS f32x4*)(dst + k * D))[tid] = v[k];
}
__device__ __forceinline__ void stage_vec(LAS float* dst, const float* src, int tid) { asm volatile("" : "+v"(tid)); ((LAS f32x4*)dst)[tid] = *((const GAS f32x4*)src + tid); }

__device__ __forceinline__ void p1_ln0(ArgsP A, LAS unsigned char* lds, int vcu, int G, int tid, int lane, int wave) {
    const float* mod = (const float*)(A->ws + WS_MOD); bf16* H = (bf16*)(A->ws + WS_H); LAS float* vec = (LAS float*)(lds + RING_OFF);
    for (int ch = vcu; ch < T / 64; ch += G) { const int r0 = ch * 64 + wave * 8, b = r0 / SEQ;
        { const float* const sv[2] = {mod + (size_t)b * D6 + D, mod + (size_t)b * D6}; stage_vecs<2>(vec, sv, tid); }
        f32x4 va[8], vb[8]; ld_row32(A->x + (size_t)r0 * D, lane, va);
        __syncthreads();
#pragma unroll 1
        for (int rr = 0; rr < 8; rr += 2) {
            ld_row32(A->x + (size_t)(r0 + rr + 1) * D, lane, vb);
            if (MK_IN_FP8) ln_mod_store(va, vec, vec + D, (bf16*)nullptr, lane, (unsigned char*)H + (size_t)(r0 + rr) * D); else ln_mod_store(va, vec, vec + D, H + (size_t)(r0 + rr) * D, lane);
            if (rr + 2 < 8) ld_row32(A->x + (size_t)(r0 + rr + 2) * D, lane, va);
            if (MK_IN_FP8) ln_mod_store(vb, vec, vec + D, (bf16*)nullptr, lane, (unsigned char*)H + (size_t)(r0 + rr + 1) * D); else ln_mod_store(vb, vec, vec + D, H + (size_t)(r0 + rr + 1) * D, lane);
        }
        __syncthreads();
    }
}

struct StaticSched {
    static constexpr bool TAILS = false; static constexpr bool PREF = false;
    int nM, nN, nwg, G, c, K; const char* Bt;
    __device__ __forceinline__ void init(int M, int N, int K_, int G_, int c_, const void* Bt_) { nM = M / 256; nN = N / 256; nwg = nM * nN; G = G_; c = c_; K = K_; Bt = (const char*)Bt_; }
    __device__ __forceinline__ bool next(int i, pg8::Unit& u) const {
        const long L = (long)i * G + c; if (L >= nwg) return false;
        int wgid = (int)L; { const int q = nwg / 8, r = nwg % 8, xcd = wgid % 8, off = wgid / 8; wgid = (xcd < r ? xcd * (q + 1) : r * (q + 1) + (xcd - r) * q) + off; }
        const int nig = 8 * nN, gid = wgid / nig, fm = gid * 8, gsz = (nM - fm) < 8 ? (nM - fm) : 8;
        u.pm = fm + ((wgid % nig) % gsz); u.pn = (wgid % nig) / gsz; u.e = 0; u.rows = 256; return true;
    }
    __device__ __forceinline__ const char* b_base(const pg8::Unit& u) const { return Bt + (size_t)u.pn * 256 * K * 2; }
    __device__ __forceinline__ void a_offs(const pg8::Unit& u, int R0, int C0, int R1, int C1, unsigned (&o)[2][2]) const {
#pragma unroll
        for (int h = 0; h < 2; ++h) { o[h][0] = (unsigned)((u.pm * 256 + h * 128 + R0) * K + C0) * 2u; o[h][1] = (unsigned)((u.pm * 256 + h * 128 + R1) * K + C1) * 2u; }
    }
};
template <bool GATHER> struct MoeSched {
    static constexpr bool TAILS = true; static constexpr bool PREF = GATHER;
    const LAS int* tp; const LAS int* cnt; const int* list; int G, c, K; const char* Bt; size_t bstride;
    __device__ __forceinline__ bool next(int i, pg8::Unit& u) const {
        const int L = i * G + c; const int total = tp[NEXP] * 8; if (L >= total) return false;
        const int mtg = L >> 3;
        int ln; asm volatile("v_mbcnt_lo_u32_b32 %0, -1, 0\n\tv_mbcnt_hi_u32_b32 %0, -1, %0" : "=v"(ln));
        const int tv = tp[ln & (NEXP - 1)];
        const int e = __builtin_popcountll(__builtin_amdgcn_ballot_w64(ln >= 1 && ln < NEXP && tv <= mtg));
        u.pm = mtg; u.pn = L & 7; u.e = e; u.rows = cnt[e] - 256 * (mtg - tp[e]); return true;
    }
    __device__ __forceinline__ const char* b_base(const pg8::Unit& u) const { return Bt + (size_t)u.e * bstride + (size_t)u.pn * 256 * K * 2; }
    __device__ __forceinline__ void a_offs(const pg8::Unit& u, int R0, int C0, int R1, int C1, unsigned (&o)[2][2]) const {
        if constexpr (GATHER) {
            const int* lp = list + (size_t)u.e * LISTCAP + 256 * (u.pm - tp[u.e]);
#pragma unroll
            for (int h = 0; h < 2; ++h) { const int i0 = h * 128 + R0, i1 = h * 128 + R1; const int t0 = i0 < u.rows ? lp[i0] : 0, t1 = i1 < u.rows ? lp[i1] : 0;
                o[h][0] = (unsigned)(t0 * K + C0) * 2u; o[h][1] = (unsigned)(t1 * K + C1) * 2u; }
        } else {
#pragma unroll
            for (int h = 0; h < 2; ++h) { o[h][0] = (unsigned)((u.pm * 256 + h * 128 + R0) * K + C0) * 2u; o[h][1] = (unsigned)((u.pm * 256 + h * 128 + R1) * K + C1) * 2u; }
        }
    }
    __device__ __forceinline__ void a_pref(const pg8::Unit& u, int R0, int R1, int (&pf)[4]) const {
        const int rm = u.rows - 1; const unsigned long long la = (unsigned long long)(list + (size_t)u.e * LISTCAP + 256 * (u.pm - tp[u.e]));
        const int* lp = (const int*)(((unsigned long long)(unsigned)__builtin_amdgcn_readfirstlane((int)(la >> 32)) << 32) | (unsigned)__builtin_amdgcn_readfirstlane((int)la));
#pragma unroll
        for (int h = 0; h < 2; ++h) { const int i0 = min(h * 128 + R0, rm) * 4, i1 = min(h * 128 + R1, rm) * 4;
            asm volatile("global_load_dword %0, %1, %2" : "=v"(pf[2 * h]) : "v"(i0), "s"(lp) : "memory");
            asm volatile("global_load_dword %0, %1, %2" : "=v"(pf[2 * h + 1]) : "v"(i1), "s"(lp) : "memory"); }
    }
    __device__ __forceinline__ void a_offs_pf(const int (&pf)[4], int C0, int C1, unsigned (&o)[2][2]) const {
#pragma unroll
        for (int h = 0; h < 2; ++h) { o[h][0] = (unsigned)(pf[2 * h] * K + C0) * 2u; o[h][1] = (unsigned)(pf[2 * h + 1] * K + C1) * 2u; }
    }
};

struct EpiProj {
    static constexpr bool PERM = true;
    bf16* P; float* flog;
    __device__ __forceinline__ void operator()(const pg8::f32x4 (&acc)[2][2][4][2], const pg8::Unit& u, int wr, int wc, int fr, int fq) const {
        const int row0 = u.pm * 256 + wr * 64 + fr;
        if (u.pn == 22) {
            if (wc == 0 && fq < 2) {
#pragma unroll
                for (int ai = 0; ai < 2; ++ai)
#pragma unroll
                    for (int m = 0; m < 4; ++m) { float* p = flog + (size_t)(8 * fq) * T + (row0 + ai * 128 + m * 16);
#pragma unroll
                        for (int n = 0; n < 2; ++n)
#pragma unroll
                            for (int i = 0; i < 4; ++i) p[(size_t)(4 * n + i) * T] = acc[ai][0][m][n][i]; }
            }
            return;
        }
        const float sc = (u.pn < 2 || (u.pn >= 6 && u.pn < 10)) ? attn_body::C2 : 1.0f;
        const int col0 = u.pn * 256 + wc * 32 + 8 * fq;
#pragma unroll
        for (int ai = 0; ai < 2; ++ai)
#pragma unroll
            for (int m = 0; m < 4; ++m) { bf16* rowp = P + (size_t)(row0 + ai * 128 + m * 16) * NPROJ + col0;
#pragma unroll
                for (int bj = 0; bj < 2; ++bj) { const pg8::f32x4 v0 = acc[ai][bj][m][0] * sc, v1 = acc[ai][bj][m][1] * sc; pg8::u32x4 w;
                    w.x = pg8::cvt_pk_bf16(v0[0], v0[1]); w.y = pg8::cvt_pk_bf16(v0[2], v0[3]); w.z = pg8::cvt_pk_bf16(v1[0], v1[1]); w.w = pg8::cvt_pk_bf16(v1[2], v1[3]);
                    *(pg8::u32x4*)(rowp + bj * 128) = w; } }
    }
};
struct EpiZ {
    static constexpr bool PERM = true;
    const float* xin32; const bf16* xin16; const float* gate  ; bf16* Z;
    __device__ __forceinline__ void operator()(const pg8::f32x4 (&acc)[2][2][4][2], const pg8::Unit& u, int wr, int wc, int fr, int fq) const {
        const int col0 = u.pn * 256 + wc * 32 + 8 * fq; const int b = (u.pm * 256) / SEQ; const float* g = gate + (size_t)b * D6;
        pg8::f32x4 gv[2][2];
#pragma unroll
        for (int bj = 0; bj < 2; ++bj)
#pragma unroll
            for (int n = 0; n < 2; ++n) gv[bj][n] = *(const GAS pg8::f32x4*)(g + col0 + bj * 128 + n * 4);
        const size_t off0 = (size_t)(u.pm * 256 + wr * 64 + fr) * D + col0;
#define EPZ_OUT(AI, M, BJ, X0, X1) do { const pg8::f32x4 z0 = (X0) * ALPHA + gv[BJ][0] * acc[AI][BJ][M][0], z1 = (X1) * ALPHA + gv[BJ][1] * acc[AI][BJ][M][1]; pg8::u32x4 w; \
            w.x = pg8::cvt_pk_bf16(z0[0], z0[1]); w.y = pg8::cvt_pk_bf16(z0[2], z0[3]); w.z = pg8::cvt_pk_bf16(z1[0], z1[1]); w.w = pg8::cvt_pk_bf16(z1[2], z1[3]); \
            *(GAS pg8::u32x4*)(Z + off0 + (size_t)((AI) * 128 + (M) * 16) * D + (BJ) * 128) = w; } while (0)
        if (xin32) {
#pragma unroll
            for (int ai = 0; ai < 2; ++ai) { pg8::f32x4 xv[4][2][2];
#pragma unroll
                for (int m = 0; m < 4; ++m)
#pragma unroll
                    for (int bj = 0; bj < 2; ++bj) { const float* p = xin32 + off0 + (size_t)(ai * 128 + m * 16) * D + bj * 128; xv[m][bj][0] = *(const GAS pg8::f32x4*)p; xv[m][bj][1] = *(const GAS pg8::f32x4*)(p + 4); }
#pragma unroll
                for (int m = 0; m < 4; ++m)
#pragma unroll
                    for (int bj = 0; bj < 2; ++bj) EPZ_OUT(ai, m, bj, xv[m][bj][0], xv[m][bj][1]); }
        } else { v4u xr[2][4][2];
#pragma unroll
            for (int ai = 0; ai < 2; ++ai)
#pragma unroll
                for (int m = 0; m < 4; ++m)
#pragma unroll
                    for (int bj = 0; bj < 2; ++bj) xr[ai][m][bj] = *(const GAS v4u*)(xin16 + off0 + (size_t)(ai * 128 + m * 16) * D + bj * 128);
#pragma unroll
            for (int ai = 0; ai < 2; ++ai)
#pragma unroll
                for (int m = 0; m < 4; ++m)
#pragma unroll
                    for (int bj = 0; bj < 2; ++bj) { const v4u r = xr[ai][m][bj]; EPZ_OUT(ai, m, bj, bf4((v2u){r.x, r.y}), bf4((v2u){r.z, r.w})); }
        }
#undef EPZ_OUT
    }
};
struct EpiHid {
    static constexpr bool PERM = true;
    unsigned char* Hd;
    __device__ __forceinline__ void operator()(const pg8::f32x4 (&acc)[2][2][4][2], const pg8::Unit& u, int wr, int wc, int fr, int fq) const {
        const int col0 = u.pn * 128 + wc * 16 + 4 * fq;
#pragma unroll
        for (int ai = 0; ai < 2; ++ai)
#pragma unroll
            for (int m = 0; m < 4; ++m) { unsigned char* rowp = Hd + (size_t)(u.pm * 256 + ai * 128 + wr * 64 + m * 16 + fr) * DEXP + col0;
#pragma unroll
                for (int bj = 0; bj < 2; ++bj) { const pg8::f32x4 a = acc[ai][bj][m][0], b = acc[ai][bj][m][1];
                    const float h0 = a[0] * __builtin_amdgcn_rcpf(1.0f + __builtin_amdgcn_exp2f(-LOG2E * a[0])) * a[1] * S_A8, h1 = a[2] * __builtin_amdgcn_rcpf(1.0f + __builtin_amdgcn_exp2f(-LOG2E * a[2])) * a[3] * S_A8;
                    const float h2 = b[0] * __builtin_amdgcn_rcpf(1.0f + __builtin_amdgcn_exp2f(-LOG2E * b[0])) * b[1] * S_A8, h3 = b[2] * __builtin_amdgcn_rcpf(1.0f + __builtin_amdgcn_exp2f(-LOG2E * b[2])) * b[3] * S_A8;
                    *(GAS unsigned*)(rowp + bj * 64) = pk4_fp8(clamp_fp8(h0), clamp_fp8(h1), clamp_fp8(h2), clamp_fp8(h3)); } }
    }
};
struct EpiY {
    static constexpr bool PERM = true;
    bf16* Y;
    __device__ __forceinline__ void operator()(const pg8::f32x4 (&acc)[2][2][4][2], const pg8::Unit& u, int wr, int wc, int fr, int fq) const {
        const int col0 = u.pn * 256 + wc * 32 + 8 * fq;
#pragma unroll
        for (int ai = 0; ai < 2; ++ai)
#pragma unroll
            for (int m = 0; m < 4; ++m) { bf16* rowp = Y + (size_t)(u.pm * 256 + ai * 128 + wr * 64 + m * 16 + fr) * D + col0;
#pragma unroll
                for (int bj = 0; bj < 2; ++bj) { const pg8::f32x4 v0 = acc[ai][bj][m][0], v1 = acc[ai][bj][m][1]; pg8::u32x4 w;
                    w.x = pg8::cvt_pk_bf16(v0[0], v0[1]); w.y = pg8::cvt_pk_bf16(v0[2], v0[3]); w.z = pg8::cvt_pk_bf16(v1[0], v1[1]); w.w = pg8::cvt_pk_bf16(v1[2], v1[3]);
                    *(pg8::u32x4*)(rowp + bj * 128) = w; } }
    }
};

__device__ __forceinline__ void cum_unit(ArgsP A, int l, int bh, LAS unsigned char* lds, int tid, int lane, int wave) {
    const int b = bh / NFH, h = bh % NFH; const float* flog = (const float*)(A->ws + WS_FLOG); float* cum = (float*)(A->ws + WS_CUM) + (size_t)bh * SEQ;
    const float bf = A->b_forget[l * NFH + h]; LAS float* wt = (LAS float*)(lds + RING_OFF);
    float v[8]; float run = 0.f;
    f32x4 fl[2]; fl[0] = *(const GAS f32x4*)(flog + (size_t)h * T + (size_t)b * SEQ + tid * 8); fl[1] = *(const GAS f32x4*)(flog + (size_t)h * T + (size_t)b * SEQ + tid * 8 + 4);
#pragma unroll
    for (int i = 0; i < 8; ++i) { const float x = fl[i >> 2][i & 3] + bf; const float ls = fminf(x, 0.f) - log1pf(__expf(-fabsf(x))); run += ls * LOG2E; v[i] = run; }
    float inc = run;
#pragma unroll
    for (int o = 1; o < 64; o <<= 1) { const float t = __int_as_float(__builtin_amdgcn_ds_bpermute(((lane - o) & 63) << 2, __float_as_int(inc))); if (lane >= o) inc += t; }
    if (lane == 63) wt[wave] = inc;
    __syncthreads();
    float off = inc - run;
    for (int w = 0; w < wave; ++w) off += wt[w];
#pragma unroll
    for (int i = 0; i < 8; ++i) cum[tid * 8 + i] = v[i] + off;
    if ((tid & 7) == 7) ((float*)(A->ws + WS_MOD + 768 * 1024))[bh * 64 + (tid >> 3)] = v[7] + off;
    __syncthreads();
}
__device__ __forceinline__ void conv_unit(ArgsP A, int l, int unit, LAS unsigned char* lds, int tid, int lane, int wave) {
    constexpr int TC = 32, ROWS = TC + CONVW - 1;
    const int t0 = unit * TC, b = t0 / SEQ, tl0 = t0 % SEQ; const bf16* P = (const bf16*)(A->ws + WS_PROJ); unsigned char* MIX = A->ws + WS_MIX;
    LAS float* part = (LAS float*)(lds + RING_OFF);
    LAS float* stat = part + NWAVES * TC * 2;
    unsigned short ra[ROWS], rg[ROWS];
#pragma unroll
    for (int r = 0; r < ROWS; ++r) { const int tl = tl0 - (CONVW - 1) + r; const bf16* row = P + (size_t)(b * SEQ + (tl < 0 ? 0 : tl)) * NPROJ; ra[r] = row[C_GA + tid]; rg[r] = row[C_GG + tid]; }
    float w[CONVW];
#pragma unroll
    for (int j = 0; j < CONVW; ++j) w[j] = A->conv_w[((size_t)l * CONVW + j) * CCH + tid];
    const float cb = A->conv_b[l * CCH + tid], lg = A->conv_ln_g[l * CCH + tid], lb = A->conv_ln_b[l * CCH + tid];
    float u[ROWS];
#pragma unroll
    for (int r = 0; r < ROWS; ++r) { const int tl = tl0 - (CONVW - 1) + r; const float a = bf2f(ra[r]), g = bf2f(rg[r]); u[r] = (tl >= 0) ? a * __builtin_amdgcn_rcpf(1.0f + __builtin_amdgcn_exp2f(-LOG2E * g)) : 0.f; }
    float y[TC];
#pragma unroll
    for (int tt = 0; tt < TC; ++tt) { float a = cb;
#pragma unroll
        for (int j = 0; j < CONVW; ++j) a += w[j] * u[tt + j];
        y[tt] = a; }
#pragma unroll
    for (int tt = 0; tt < TC; ++tt) { const float s = wave_sum(y[tt]), s2 = wave_sum(y[tt] * y[tt]); if (lane == 0) { part[(wave * TC + tt) * 2] = s; part[(wave * TC + tt) * 2 + 1] = s2; } }
    __syncthreads();
    if (tid < TC) { float s = 0.f, s2 = 0.f;
#pragma unroll
        for (int wv = 0; wv < NWAVES; ++wv) { s += part[(wv * TC + tid) * 2]; s2 += part[(wv * TC + tid) * 2 + 1]; }
        const float mean = s * (1.f / CCH); const float var = fmaxf(s2 * (1.f / CCH) - mean * mean, 0.f); stat[tid * 2] = mean; stat[tid * 2 + 1] = 1.f / sqrtf(var + LN_EPS); }
    __syncthreads();
#pragma unroll
    for (int tt = 0; tt < TC; ++tt) { const float v = (y[tt] - stat[tt * 2]) * stat[tt * 2 + 1] * lg + lb; const float o = v * __builtin_amdgcn_rcpf(1.0f + __builtin_amdgcn_exp2f(-LOG2E * v));
        MIX[(size_t)(t0 + tt) * D + O_CV + tid] = (unsigned char)(__builtin_amdgcn_cvt_pk_fp8_f32(clamp_fp8(o * attn_body::O_SCALE), 0.f, 0, false) & 0xff); }
    __syncthreads();
}

__device__ __forceinline__ void p6_ln_route(ArgsP A, int l, LAS unsigned char* lds, int vcu, int G, int tid, int lane, int wave) {
    unsigned char* ws = A->ws; const bf16* Z = (const bf16*)(ws + WS_Z); bf16* X1 = (bf16*)(ws + WS_X1); bf16* H = (bf16*)(ws + WS_H);
    const float* mod = (const float*)(ws + WS_MOD) + (size_t)l * BATCH * D6; const bf16* rwt = (const bf16*)(ws + WS_RWT) + (size_t)l * 96 * D;
    gu32* cntw = (gu32*)(ws + WS_CTL) + CW_CNT + l * NEXP * 64; int* list = (int*)(ws + WS_LIST); unsigned* rte = (unsigned*)(ws + WS_ROUTE); float* rtw = (float*)(ws + WS_ROUTE + 256 * 1024);
    const float* g1 = A->ln1_g + (size_t)l * D; const float* b1 = A->ln1_b + (size_t)l * D;
    LAS float* lg = (LAS float*)(lds + RING_OFF);
    LAS unsigned* lcnt = (LAS unsigned*)(lds + RING_OFF + 2 * 64 * 48 * 4); LAS unsigned* lbase = lcnt + NEXP;
    LAS float* vec = (LAS float*)(lds + RING_OFF + 32768);
    for (int ch = vcu; ch < T / 64; ch += G) {
        const int r0 = ch * 64, b = r0 / SEQ;
        { const float* const sv[4] = {g1, b1, mod + (size_t)b * D6 + 4 * D, mod + (size_t)b * D6 + 3 * D}; stage_vecs<4>(vec, sv, tid); }
        { const int m0 = r0 + wave * 8; v2u za[8], zb[8]; ld_row16(Z + (size_t)m0 * D, lane, za); ld_row16(Z + (size_t)(m0 + 1) * D, lane, zb);
          __syncthreads();
#define RT_ROW(ZR, RR, NXT) do { f32x4 v[8]; const LAS float* vr = vec; asm volatile("" : "+v"(vr)); \
              _Pragma("unroll") for (int j = 0; j < 8; ++j) v[j] = bf4(ZR[j]); \
              if ((NXT) < 8) ld_row16(Z + (size_t)(m0 + (NXT)) * D, lane, ZR); \
              float mean, rstd; row_stats(v, mean, rstd); \
              _Pragma("unroll") for (int j = 0; j < 8; ++j) { const f32x4 g = *((const LAS f32x4*)vr + lane + 64 * j), bb = *((const LAS f32x4*)(vr + D) + lane + 64 * j); v[j] = (v[j] - mean) * rstd * g + bb; } \
              ln_mod_store(v, vr + 2 * D, vr + 3 * D, H + (size_t)(m0 + (RR)) * D, lane, MK_GU_FP8 ? ws + WS_H8 + (size_t)(m0 + (RR)) * D : (unsigned char*)nullptr); } while (0)
#pragma unroll 1
          for (int rr = 0; rr < 8; rr += 2) { RT_ROW(za, rr, rr + 2); RT_ROW(zb, rr + 1, rr + 3); }
#undef RT_ROW
        }
        VM_WAIT(); __syncthreads();
        { constexpr int KC = 128, PB = KC * 2 + 16  , NROW = 64 + 96, CHB = NROW * PB;
          LAS unsigned char* rbuf = lds + RING_OFF + 32768;
          const int rt = wave & 3, part = wave >> 2, fr = lane & 15, fq = lane >> 4;
          f32x4 acc[3]; acc[0] = acc[1] = acc[2] = (f32x4){0.f, 0.f, 0.f, 0.f};
          v4u pa[5], pb[5];
          constexpr int NCH = D / KC;
#define RT_LOAD(P, c) do { const int cc_ = (c) < NCH ? (c) : NCH - 1; _Pragma("unroll") for (int i = 0; i < 5; ++i) { const int p = tid + 512 * i, row = p >> 4, seg = p & 15; \
              const bf16* src = (row < 64 ? H + (size_t)(r0 + row) * D : rwt + (size_t)(row - 64) * D) + cc_ * KC + seg * 8; P[i] = *(const GAS v4u*)src; } } while (0)
#define RT_PUT(P, b) do { _Pragma("unroll") for (int i = 0; i < 5; ++i) { const int p = tid + 512 * i, row = p >> 4, seg = p & 15; *(LAS v4u*)(rbuf + (b) * CHB + row * PB + seg * 16) = P[i]; } } while (0)
#define RT_COMP(b) do { const LAS unsigned char* hb = rbuf + (b) * CHB + (rt * 16 + fr) * PB + fq * 16; const LAS unsigned char* wb = rbuf + (b) * CHB + (64 + part * 48 + fr) * PB + fq * 16; \
              _Pragma("unroll") for (int j = 0; j < KC / 32; ++j) { const bf16x8 hf = *(const LAS bf16x8*)(hb + j * 64); \
                  _Pragma("unroll") for (int nt = 0; nt < 3; ++nt) { const bf16x8 wf = *(const LAS bf16x8*)(wb + nt * 16 * PB + j * 64); acc[nt] = __builtin_amdgcn_mfma_f32_16x16x32_bf16(wf, hf, acc[nt], 0, 0, 0); } } } while (0)
          __syncthreads();
          RT_LOAD(pa, 0); RT_LOAD(pb, 1); RT_PUT(pa, 0); RT_PUT(pb, 1); RT_LOAD(pa, 2); RT_LOAD(pb, 3); LDS_BARRIER();
#pragma unroll 1
          for (int c = 0; c < NCH; c += 2) {
              RT_COMP(0); LDS_BARRIER(); RT_PUT(pa, 0); RT_LOAD(pa, c + 4);
              RT_COMP(1); LDS_BARRIER(); RT_PUT(pb, 1); RT_LOAD(pb, c + 5);
          }
#undef RT_LOAD
#undef RT_PUT
#undef RT_COMP
#pragma unroll
          for (int nt = 0; nt < 3; ++nt)
#pragma unroll
              for (int i = 0; i < 4; ++i) lg[(part * 64 + rt * 16 + fr) * 48 + nt * 16 + 4 * fq + i] = acc[nt][i]; }
        __syncthreads();
        int ex0 = 0, ex1 = 0; unsigned lr0 = 0u, lr1 = 0u;
        if (tid < NEXP) lcnt[tid] = 0u;
        __syncthreads();
        if (tid < 64) { const int tok = r0 + tid; float L[36];
#pragma unroll
            for (int n = 0; n < 36; ++n) L[n] = lg[tid * 48 + n] + lg[(64 + tid) * 48 + n];
            float l1[4]; int grp = 0; float mx = -INFINITY;
#pragma unroll
            for (int g = 0; g < 4; ++g) { l1[g] = L[g] + A->r1_b[l * 4 + g]; if (l1[g] > mx) { mx = l1[g]; grp = g; } }
            float den = 0.f;
#pragma unroll
            for (int g = 0; g < 4; ++g) den += __expf(l1[g] - mx);
            const float pgrp = 1.0f / den;
            float l2[8]; float m2 = -INFINITY;
#pragma unroll
            for (int e = 0; e < 8; ++e) { float v = 0.f;
#pragma unroll
                for (int g = 0; g < 4; ++g) v = (g == grp) ? L[4 + 8 * g + e] : v;
                l2[e] = v + A->r2_b[(l * 4 + grp) * 8 + e]; m2 = fmaxf(m2, l2[e]); }
            int e0 = 0, e1 = 0; float v0 = -INFINITY, v1 = -INFINITY;
#pragma unroll
            for (int e = 0; e < 8; ++e) { const float v = l2[e]; if (v > v0) { v1 = v0; e1 = e0; v0 = v; e0 = e; } else if (v > v1) { v1 = v; e1 = e; } }
            const float p0 = __expf(v0 - m2), p1 = __expf(v1 - m2); const float w0 = pgrp * p0 / (p0 + p1), w1 = pgrp * p1 / (p0 + p1);
            ex0 = grp * 8 + e0; ex1 = grp * 8 + e1;
            lr0 = __hip_atomic_fetch_add(lcnt + ex0, 1u, __ATOMIC_RELAXED, __HIP_MEMORY_SCOPE_WORKGROUP); lr1 = __hip_atomic_fetch_add(lcnt + ex1, 1u, __ATOMIC_RELAXED, __HIP_MEMORY_SCOPE_WORKGROUP);
            rtw[tok * 2] = w0; rtw[tok * 2 + 1] = w1; }
        __syncthreads();
        if (tid < NEXP) { const unsigned c = lcnt[tid]; unsigned base = 0u; if (c) base = __hip_atomic_fetch_add(cntw + tid * 64, c, RLX_AGENT); lbase[tid] = base; }
        __syncthreads();
        if (tid < 64) { const int tok = r0 + tid; const unsigned s0 = lbase[ex0] + lr0, s1 = lbase[ex1] + lr1;
            list[(size_t)ex0 * LISTCAP + s0] = tok; list[(size_t)ex1 * LISTCAP + s1] = tok;
            rte[tok * 2] = ((unsigned)ex0 << 16) | s0; rte[tok * 2 + 1] = ((unsigned)ex1 << 16) | s1; }
        __syncthreads();
    }
}
__device__ __forceinline__ void moe_table(ArgsP A, int l, LAS unsigned char* lds, int tid) {
    LAS int* tp = (LAS int*)(lds + MOE_OFF); LAS int* cn = tp + 40;
    if (tid < NEXP) { const gu32* cntw = (const gu32*)(A->ws + WS_CTL) + CW_CNT + l * NEXP * 64; cn[tid] = (int)__hip_atomic_load(cntw + tid * 64, RLX_AGENT); }
    __syncthreads();
    if (tid <= NEXP) { int s = 0;
#pragma unroll 1
        for (int j = 0; j < tid; ++j) s += (cn[j] + 255) >> 8;
        tp[tid] = s; }
    __syncthreads();
}

struct CombRow { v2u x[8], ya[8], yb[8]; float wa, wb; };
__device__ __forceinline__ void comb_load(CombRow& R, int m, const bf16* X1, const bf16* Y, const unsigned* rte, const float* rtw, const LAS int* tpl, int lane) {
    const unsigned ra = rte[m * 2], rb = rte[m * 2 + 1]; R.wa = rtw[m * 2]; R.wb = rtw[m * 2 + 1];
    const int rowa = 256 * tpl[ra >> 16] + (int)(ra & 0xffffu), rowb = 256 * tpl[rb >> 16] + (int)(rb & 0xffffu);
    ld_row16(X1 + (size_t)m * D, lane, R.x); ld_row16(Y + (size_t)rowa * D, lane, R.ya); ld_row16(Y + (size_t)rowb * D, lane, R.yb);
}
__device__ __forceinline__ void comb_mix(const CombRow& R, const LAS float* vec, f32x4 (&v)[8], int lane) {
#pragma unroll
    for (int j = 0; j < 8; ++j) v[j] = bf4(R.x[j]);
    float mean, rstd; row_stats(v, mean, rstd);
#pragma unroll
    for (int j = 0; j < 8; ++j) { const f32x4 g1 = *((const LAS f32x4*)(vec + 5 * D) + lane + 64 * j), b1 = *((const LAS f32x4*)(vec + 6 * D) + lane + 64 * j), g = *((const LAS f32x4*)vec + lane + 64 * j);
        const f32x4 x1 = (v[j] - mean) * rstd * g1 + b1; v[j] = x1 * ALPHA + g * (bf4(R.ya[j]) * R.wa + bf4(R.yb[j]) * R.wb); }
}
__device__ __forceinline__ void comb_fin(f32x4 (&v)[8], int m, int l, const LAS float* vec, float* XO32, bf16* XO16, bf16* H, int lane) {
    float mean, rstd; row_stats(v, mean, rstd);
#pragma unroll
    for (int j = 0; j < 8; ++j) { const f32x4 g = *((const LAS f32x4*)(vec + D) + lane + 64 * j), bb = *((const LAS f32x4*)(vec + 2 * D) + lane + 64 * j); v[j] = (v[j] - mean) * rstd * g + bb; }
    if (l == DEPTH - 1) {
#pragma unroll
        for (int j = 0; j < 8; ++j) *((GAS f32x4*)(XO32 + (size_t)m * D) + lane + 64 * j) = v[j];
    } else { st_row16(XO16 + (size_t)m * D, lane, v);
        if (MK_IN_FP8) ln_mod_store(v, vec + 3 * D, vec + 4 * D, (bf16*)nullptr, lane, (unsigned char*)H + (size_t)m * D); else ln_mod_store(v, vec + 3 * D, vec + 4 * D, H + (size_t)m * D, lane); }
}
__device__ __forceinline__ void p9_combine(ArgsP A, int l, LAS unsigned char* lds, int vcu, int G, int tid, int lane, int wave) {
    unsigned char* ws = A->ws; const bf16* X1 = (const bf16*)(ws + WS_Z)  ; const bf16* Y = (const bf16*)(ws + WS_Y); bf16* H = (bf16*)(ws + WS_H);
    const float* mod = (const float*)(ws + WS_MOD) + (size_t)l * BATCH * D6; const float* modn = (const float*)(ws + WS_MOD) + (size_t)(l + 1 < DEPTH ? l + 1 : l) * BATCH * D6;
    const unsigned* rte = (const unsigned*)(ws + WS_ROUTE); const float* rtw = (const float*)(ws + WS_ROUTE + 256 * 1024);
    LAS float* vec = (LAS float*)(lds + RING_OFF);
    moe_table(A, l, lds, tid); const LAS int* tpl = (const LAS int*)(lds + MOE_OFF);
    for (int ch = vcu; ch < T / 64; ch += G) { const int r0 = ch * 64 + wave * 8, b = r0 / SEQ;
        { const float* const sv[7] = {mod + (size_t)b * D6 + 5 * D, A->ln2_g + (size_t)l * D, A->ln2_b + (size_t)l * D, modn + (size_t)b * D6 + D, modn + (size_t)b * D6, A->ln1_g + (size_t)l * D, A->ln1_b + (size_t)l * D};
          stage_vecs<7>(vec, sv, tid); }
        CombRow R; comb_load(R, r0, X1, Y, rte, rtw, tpl, lane);
        __syncthreads();
#pragma unroll 1
        for (int rr = 0; rr < 8; ++rr) {
            const LAS float* vr = vec; asm volatile("" : "+v"(vr));
            f32x4 v[8]; comb_mix(R, vr, v, lane);
            if (rr + 1 < 8) comb_load(R, r0 + rr + 1, X1, Y, rte, rtw, tpl, lane);
            comb_fin(v, r0 + rr, l, vr, A->out, (bf16*)(ws + WS_X2), H, lane);
        }
        __syncthreads();
    }
}

#define PH_BEGIN() ArgsP A = kargs(); unsigned char* ws = A->ws; int tid; asm volatile("v_mbcnt_lo_u32_b32 %0, -1, 0\n\tv_mbcnt_hi_u32_b32 %0, -1, %0" : "=v"(tid)); tid += wave0 * 64; const int lane = tid & 63, wave = __builtin_amdgcn_readfirstlane(tid >> 6); (void)lane; (void)wave; (void)ws
__global__ void __launch_bounds__(NTHR, 2) mk_fwd(Args args) {
    extern __shared__ __attribute__((aligned(16))) unsigned char lds_raw[];
    LAS unsigned char* lds = (LAS unsigned char*)lds_raw;
    volatile LAS unsigned* MISC = (volatile LAS unsigned*)(lds + MISC_OFF);
    const int G = gridDim.x; const int bx = blockIdx.x; const int vcu = (G % 8 == 0) ? (bx % 8) * (G / 8) + bx / 8 : bx;
    const int wave0 = __builtin_amdgcn_readfirstlane((int)threadIdx.x >> 6);
    for (int u = threadIdx.x; u < (LDS_BYTES - LDSCTL_OFF) / 4; u += NTHR) ((LAS unsigned*)(lds + LDSCTL_OFF))[u] = 0u;
    __syncthreads();
    XcdBarrier bar; bar.bar = (gu32*)(args.ws + WS_CTL) + CW_BAR; bar.x = 0; bar.st = nullptr;
    if (!MK_PER_PHASE) bar = xcd_barrier_post(bar.bar, MISC + 8, threadIdx.x == 0);
    const int lo = args.ph_lo, hi = args.ph_hi;
#ifndef MK_ATT_FOX
#define MK_ATT_FOX 1
#endif
#ifndef MK_ATT_SB
#define MK_ATT_SB 1
#endif
#ifndef MK_MASK
#define MK_MASK 0x3ff
#endif
#define EN(j) (((MK_MASK) >> (j)) & 1)
#ifndef MK_DUP
#define MK_DUP 0
#endif
#if MK_DUP
#define REP(j) for (int rep_ = 0, nrep_ = 1 + ((kargs()->dup >> (j)) & 1); rep_ < nrep_; ++rep_)
#else
#define REP(j)
#endif
#define IN(k) (lo <= (k) && (k) < hi)
#define SEAM(k) do { if (IN(k) && IN((k) + 1)) xcd_barrier(bar, tid == 0); } while (0)

    if (EN(0) && IN(0)) REP(0) { PH_BEGIN(); p0_prologue(A, lds, vcu, G, tid, lane, wave); SEAM(0); }
    if (EN(1) && IN(1)) REP(1) { PH_BEGIN(); p1_ln0(A, lds, vcu, G, tid, lane, wave); SEAM(1); }
#pragma unroll 1
    for (int l = 0; l < DEPTH; ++l) {
        const int pb = 2 + 8 * l;
        if (EN(2) && IN(pb)) REP(2) { PH_BEGIN();
            EpiProj E{(bf16*)(ws + WS_PROJ), (float*)(ws + WS_FLOG)};
#if MK_IN_FP8
            StaticSched S; S.init(T, NPROJ_PAD, D / 2, G, bx, ws + WS_WIN + (size_t)l * NPROJ_PAD * D);
            pg8::gemm_phase<EpiProj, StaticSched, true, true, 0, 0>(lds + RING_OFF, (const char*)(ws + WS_H), D / 2, S, E, tid);
#else
            StaticSched S; S.init(T, NPROJ_PAD, D, G, bx, (const bf16*)(ws + WS_WIN) + (size_t)l * NPROJ_PAD * D);
            pg8::gemm_phase<EpiProj, StaticSched, true>(lds + RING_OFF, (const char*)(ws + WS_H), D, S, E, tid);
#endif
            { pg8::Unit ux; if (!S.next((T / 256) * (NPROJ_PAD / 256) / G, ux)) convert_claim(A, l, 7, lds, tid, wave); }
            SEAM(pb);
        }
        if (EN(3) && IN(pb + 1)) REP(3) { PH_BEGIN();
            for (int u = vcu; u < BATCH * NFH; u += G) cum_unit(A, l, u, lds, tid, lane, wave);
            for (int u = vcu; u < T / 32; u += G) conv_unit(A, l, u, lds, tid, lane, wave);
            SEAM(pb + 1);
        }
#if MK_DUP
        if (EN(4) && IN(pb + 2)) for (int rep_ = 0, nrep_ = 1 + (((kargs()->dup >> 10) & 3) != 0); rep_ < nrep_; ++rep_) { PH_BEGIN(); const int dupa = (A->dup >> 10) & 3;
#else
        if (EN(4) && IN(pb + 2)) { PH_BEGIN(); constexpr int rep_ = 0, dupa = 0;
#endif
            const attn_body::bf16* P = (const attn_body::bf16*)(ws + WS_PROJ); unsigned char* MIX = ws + WS_MIX; const float* cum = (const float*)(ws + WS_CUM);
            gu32* qctr = (gu32*)(ws + WS_CTL) + CW_Q + (l * 2 + rep_) * 64; LAS unsigned* tk = (LAS unsigned*)(lds + MISC_OFF + 64);
            for (;;) {
                if (tid == 0) *tk = __hip_atomic_fetch_add(qctr, 1u, RLX_AGENT);
                __syncthreads();
                const unsigned idx = (unsigned)__builtin_amdgcn_readfirstlane((int)*tk);
                __syncthreads();
                if (idx >= 1536u) break;
                const int qb = 15 - (int)(idx / 96u), r = (int)(idx % 96u);
                if (r < 64) { const int b = r / NFH, h = r % NFH;
                    if (MK_ATT_FOX && (rep_ == 0 || (dupa & 1))) attn_body::fox_unit<8>(b, qb, P + C_QFX + h * 64, P + C_KFX + h * 64, P + C_VFX + h * 64, MIX + O_FX + h * 64, cum + (size_t)r * SEQ, (const float*)(ws + WS_MOD + 768 * 1024) + r * 64, (char*)lds_raw + RING_OFF, tid);
                } else { const int bh = r - 64, b = bh / 8, h = bh % 8;
                    if (MK_ATT_SB && (rep_ == 0 || (dupa & 2))) attn_body::sb_unit(b, qb, P + C_QSB + h * 64, P + C_KSB + h * 64, P + C_VSB + h * 64, MIX + O_SB + h * 64, (char*)lds_raw + RING_OFF, tid);
                }
                if (rep_ == 0) { static_assert(N_XTILE == 1536 * 4, "four conversion tiles per attention ticket cover every tile"); convert_claim(A, l, 4, lds, tid, wave); }
            }
            SEAM(pb + 2);
        }
        if (EN(5) && IN(pb + 3)) REP(5) { PH_BEGIN();
            StaticSched S; S.init(T, D, D / 2, G, bx, ws + WS_WOUT + (size_t)l * D * D);
            EpiZ E{l == 0 ? A->x : (const float*)nullptr, (const bf16*)(ws + WS_X2), (const float*)(ws + WS_MOD) + (size_t)l * BATCH * D6 + 2 * D, (bf16*)(ws + WS_Z)};
            pg8::gemm_phase<EpiZ, StaticSched, false, true, 0, 0>(lds + RING_OFF, (const char*)(ws + WS_MIX), D / 2, S, E, tid);
            SEAM(pb + 3);
        }
        if (EN(6) && IN(pb + 4)) { PH_BEGIN(); p6_ln_route(A, l, lds, vcu, G, tid, lane, wave); SEAM(pb + 4); }
        if (EN(7) && IN(pb + 5)) REP(7) { PH_BEGIN();
            moe_table(A, l, lds, tid);
#if MK_GU_FP8
            MoeSched<true> S{(const LAS int*)(lds + MOE_OFF), (const LAS int*)(lds + MOE_OFF) + 40, (const int*)(ws + WS_LIST), G, bx, D / 2, (const char*)(ws + WS_WGU) + (size_t)l * NEXP * 2048 * 2048, (size_t)2048 * 2048};
            EpiHid E{ws + WS_HID};
            pg8::gemm_phase<EpiHid, MoeSched<true>, true, true, 0, 0>(lds + RING_OFF, (const char*)(ws + WS_H8), D / 2, S, E, tid);
            if (l + 1 < DEPTH) { const int total = ((const LAS int*)(lds + MOE_OFF))[NEXP] * 8; if (total % G != 0 && bx >= total % G) convert_claim(A, l + 1, 6, lds, tid, wave); }
#else
            MoeSched<true> S{(const LAS int*)(lds + MOE_OFF), (const LAS int*)(lds + MOE_OFF) + 40, (const int*)(ws + WS_LIST), G, bx, D, (const char*)(ws + WS_WGU) + (size_t)l * NEXP * 2048 * 2048 * 2, (size_t)2048 * 2048 * 2};
            EpiHid E{ws + WS_HID};
            pg8::gemm_phase<EpiHid, MoeSched<true>, true>(lds + RING_OFF, (const char*)(ws + WS_H), D, S, E, tid);
#endif
            SEAM(pb + 5);
        }
        if (EN(8) && IN(pb + 6)) REP(8) { PH_BEGIN();
            moe_table(A, l, lds, tid);
            MoeSched<false> S{(const LAS int*)(lds + MOE_OFF), (const LAS int*)(lds + MOE_OFF) + 40, (const int*)(ws + WS_LIST), G, bx, DEXP / 2, (const char*)(ws + WS_WDN) + (size_t)l * NEXP * 2048 * 1024, (size_t)2048 * 1024};
            EpiY E{(bf16*)(ws + WS_Y)};
            pg8::gemm_phase<EpiY, MoeSched<false>, true, true, 0, 0>(lds + RING_OFF, (const char*)(ws + WS_HID), DEXP / 2, S, E, tid);
            if (l + 1 < DEPTH) { const int total = ((const LAS int*)(lds + MOE_OFF))[NEXP] * 8; if (total % G != 0 && bx >= total % G) convert_claim(A, l + 1, 4, lds, tid, wave); }
            SEAM(pb + 6);
        }
        if (EN(9) && IN(pb + 7)) REP(9) { PH_BEGIN(); p9_combine(A, l, lds, vcu, G, tid, lane, wave); SEAM(pb + 7); }
    }
#undef IN
#undef SEAM
}

extern "C" void kernel_launch(void* const* d_in, const int* in_sizes, int n_in, void* d_out, int out_size, void* d_ws, size_t ws_size, hipStream_t stream) {
    static int grid = 0;
    if (grid == 0) {
        if (n_in != 22 || in_sizes[0] != T * D || out_size != T * D || ws_size < WS_END) { fprintf(stderr, "kernel_launch: unexpected shapes / workspace (n_in %d, in0 %d, out %d, ws %zu, need %zu); nothing launched\n", n_in, n_in > 0 ? in_sizes[0] : -1, out_size, ws_size, (size_t)WS_END); grid = -1; return; }
        int dev = 0, cus = 0, per_cu = 0;
        if (hipGetDevice(&dev) != hipSuccess || hipDeviceGetAttribute(&cus, hipDeviceAttributeMultiprocessorCount, dev) != hipSuccess) { grid = -1; return; }
        if (hipFuncSetAttribute((const void*)mk_fwd, hipFuncAttributeMaxDynamicSharedMemorySize, LDS_BYTES) != hipSuccess) { fprintf(stderr, "kernel_launch: hipFuncSetAttribute failed\n"); grid = -1; return; }
        if (hipOccupancyMaxActiveBlocksPerMultiprocessor(&per_cu, (const void*)mk_fwd, NTHR, LDS_BYTES) != hipSuccess || per_cu < 1) fprintf(stderr, "kernel_launch: occupancy query reports %d blocks per CU\n", per_cu);
        (void)hipGetLastError();
        grid = cus;
    }
    if (grid < 0) return;
    if (hipMemsetAsync((char*)d_ws + WS_CTL, 0, CTL_ZERO_BYTES, stream) != hipSuccess) return;
    Args a{};
    const float** ap = (const float**)&a;
    for (int i = 0; i < 22; ++i) ap[i] = (const float*)d_in[i];
    a.out = (float*)d_out; a.ws = (unsigned char*)d_ws; a.dup = MK_DUP; a.pad = 0;
#if MK_PER_PHASE
    for (int p = 0; p < NPHASE; ++p) { a.ph_lo = p; a.ph_hi = p + 1; hipLaunchKernelGGL(mk_fwd, dim3(grid), dim3(NTHR), LDS_BYTES, stream, a); }
#else
    a.ph_lo = 0; a.ph_hi = NPHASE; hipLaunchKernelGGL(mk_fwd, dim3(grid), dim3(NTHR), LDS_BYTES, stream, a);
#endif
}
```

```cpp
#include <hip/hip_runtime.h>
#include <hip/hip_bf16.h>
#include <cstdio>
#include <cstdint>
#include <cmath>
namespace pg8 {
#define PG8_LAS __attribute__((address_space(3)))
typedef unsigned short bf16_t;
typedef short bf16x8 __attribute__((ext_vector_type(8)));
typedef float f32x4 __attribute__((ext_vector_type(4)));
typedef unsigned u32x4 __attribute__((ext_vector_type(4)));
typedef int v4i_t __attribute__((ext_vector_type(4)));
typedef int v8i_t __attribute__((ext_vector_type(8)));
constexpr int BM = 256, BK = 64, HALF = 128, HTB = HALF * BK * 2  , STAGE_BYTES = 8 * HTB, NXCD = 8, WGM = 8;

__host__ __device__ __forceinline__ int lds_byte(int r, int c) { const int st = (r >> 4) * 2 + (c >> 5), rr = r & 15, cc = c & 31, ob = rr * 64 + cc * 2; return st * 1024 + (ob ^ (((ob >> 9) & 1) << 5)); }
__host__ __device__ __forceinline__ void stage_rc(int b, int& R, int& C) { const int st = b / 1024, sb = b % 1024, swz = sb ^ (((sb >> 9) & 1) << 5); R = (st >> 1) * 16 + swz / 64; C = (st & 1) * 32 + (swz % 64) / 2; }
__host__ __device__ __forceinline__ int perm32(int rho) { const int n = rho >> 4, i = rho & 15; return 8 * (i >> 2) + 4 * n + (i & 3); }

struct Unit { int pm, pn, e, rows; };

__device__ __forceinline__ unsigned cvt_pk_bf16(float lo, float hi) { unsigned r; asm volatile("v_cvt_pk_bf16_f32 %0, %1, %2" : "=v"(r) : "v"(lo), "v"(hi)); return r; }

__device__ __forceinline__ void glds_s(const char* sbase, unsigned voff, unsigned lds_dst) { unsigned keep;
    asm volatile("s_mov_b32 %0, m0\n\ts_mov_b32 m0, %3\n\ts_nop 0\n\tglobal_load_lds_dwordx4 %1, %2\n\ts_mov_b32 m0, %0" : "=&s"(keep) : "v"(voff), "s"(sbase), "s"(lds_dst) : "memory"); }
template <class Epi, class Sched, bool ALIGN_EPI, bool FP8 = false, int SCW = 127, int SCA = 127>
__device__ __forceinline__ void gemm_phase(PG8_LAS unsigned char* lds, const char* Abase, const int K, const Sched& S, const Epi& E, const int tid_in) {
    int tid = tid_in; asm volatile("" : "+v"(tid), "+s"(Abase));
    const int wid = __builtin_amdgcn_readfirstlane(tid >> 6), lane = tid & 63, wr = wid >> 2, wc = wid & 3, fr = lane & 15, fq = lane >> 4;
    int scw = SCW, sca = SCA; asm volatile("" : "+v"(scw), "+v"(sca));
    (void)scw; (void)sca;
    const int nt = K / BK;
    int Rs[2], Cs[2]; unsigned voffB[2];
#pragma unroll
    for (int i = 0; i < 2; ++i) { int R, C; stage_rc(tid * 16 + i * 8192, R, C); const int Rb = Epi::PERM ? ((R & ~31) + perm32(R & 31)) : R; Rs[i] = R; Cs[i] = C; voffB[i] = (unsigned)(Rb * K + C) * 2u; }
    const size_t kstep = (size_t)(BK * 2);
    const size_t hstep = (size_t)HALF * K * 2;
    const unsigned ldsb = (unsigned)(size_t)lds + (unsigned)wid * 1024u;
    const int aoff = lds_byte(wr * 64 + fr, fq * 8), boff = lds_byte(wc * 32 + fr, fq * 8) + 4 * HTB;
    int aoff_ = aoff, boff_ = boff; asm volatile("" : "+v"(aoff_), "+v"(boff_));
#define PG8_SA(b, h) (((b) * 2 + (h)) * HTB)
#define PG8_SB(b, h) ((4 + (b) * 2 + (h)) * HTB)
#define PG8_SBR(b, h) (((b) * 2 + (h)) * HTB)
#define PG8_STAGE(bufoff, gbase, voff) do { _Pragma("unroll") for (int _i = 0; _i < 2; ++_i) \
        glds_s((const char*)(gbase), (voff)[_i], ldsb + (unsigned)((bufoff) + _i * 8192)); } while (0)
#define PG8_L16(off) (*(const PG8_LAS v4i_t*)(lds + (off)))
#define PG8_CAT(lo, hi) __builtin_shufflevector(lo, hi, 0, 1, 2, 3, 4, 5, 6, 7)
#define PG8_LDA(dst, b, h) do { if constexpr (FP8) { _Pragma("unroll") for (int m = 0; m < 4; ++m) dst##8[m] = PG8_CAT(PG8_L16(aoff_ + PG8_SA(b, h) + m * 2048), PG8_L16(aoff_ + PG8_SA(b, h) + m * 2048 + 1024)); } \
        else { _Pragma("unroll") for (int m = 0; m < 4; ++m) _Pragma("unroll") for (int k = 0; k < 2; ++k) dst[m][k] = *(const PG8_LAS bf16x8*)(lds + aoff_ + (PG8_SA(b, h) + m * 2048 + k * 1024)); } } while (0)
#define PG8_LDB(dst, b, h) do { if constexpr (FP8) { _Pragma("unroll") for (int n = 0; n < 2; ++n) dst##8[n] = PG8_CAT(PG8_L16(boff_ + PG8_SBR(b, h) + n * 2048), PG8_L16(boff_ + PG8_SBR(b, h) + n * 2048 + 1024)); } \
        else { _Pragma("unroll") for (int n = 0; n < 2; ++n) _Pragma("unroll") for (int k = 0; k < 2; ++k) dst[n][k] = *(const PG8_LAS bf16x8*)(lds + boff_ + (PG8_SBR(b, h) + n * 2048 + k * 1024)); } } while (0)
#define PG8_MMA(ai, bj, At, Bt) do { __builtin_amdgcn_s_setprio(1); \
        if constexpr (FP8) { _Pragma("unroll") for (int m = 0; m < 4; ++m) _Pragma("unroll") for (int n = 0; n < 2; ++n) \
            { if constexpr (SCW == 0) acc[ai][bj][m][n] = __builtin_amdgcn_mfma_scale_f32_16x16x128_f8f6f4(Bt##8[n], At##8[m], acc[ai][bj][m][n], 0, 0, 0, 0, 0, 0); \
              else acc[ai][bj][m][n] = __builtin_amdgcn_mfma_scale_f32_16x16x128_f8f6f4(Bt##8[n], At##8[m], acc[ai][bj][m][n], 0, 0, 0, scw, 0, sca); } } \
        else { _Pragma("unroll") for (int m = 0; m < 4; ++m) _Pragma("unroll") for (int n = 0; n < 2; ++n) _Pragma("unroll") for (int k = 0; k < 2; ++k) \
            acc[ai][bj][m][n] = __builtin_amdgcn_mfma_f32_16x16x32_bf16(Bt[n][k], At[m][k], acc[ai][bj][m][n], 0, 0, 0); } \
        __builtin_amdgcn_s_setprio(0); } while (0)
#define PG8_WAIT_V(n) asm volatile("s_waitcnt vmcnt(" #n ")" ::: "memory")
#define PG8_WAIT_L(n) asm volatile("s_waitcnt lgkmcnt(" #n ")" ::: "memory")
#define PG8_BAR __builtin_amdgcn_s_barrier()
#define PG8_SCHED __builtin_amdgcn_sched_barrier(0)
    Unit cur, nxt; int ui = 0;
    if (!S.next(0, cur)) return;
    f32x4 acc[2][2][4][2];
#pragma unroll
    for (int a = 0; a < 2; ++a)
#pragma unroll
        for (int b = 0; b < 2; ++b)
#pragma unroll
            for (int m = 0; m < 4; ++m)
#pragma unroll
                for (int n = 0; n < 2; ++n) { float z0, z1, z2, z3; asm volatile("v_mov_b32 %0, 0\n\tv_mov_b32 %1, 0\n\tv_mov_b32 %2, 0\n\tv_mov_b32 %3, 0" : "=v"(z0), "=v"(z1), "=v"(z2), "=v"(z3)); acc[a][b][m][n] = (f32x4){z0, z1, z2, z3}; }
    bf16x8 At[4][2], B0[2][2], B1[2][2]; v8i_t At8[4], B08[2], B18[2];
    unsigned cvA[2][2]; int pf[4];
    S.a_offs(cur, Rs[0], Cs[0], Rs[1], Cs[1], cvA);
    const char* cB = S.b_base(cur);
    PG8_STAGE(PG8_SB(0, 0), cB, voffB); PG8_STAGE(PG8_SB(0, 1), cB + hstep, voffB); PG8_STAGE(PG8_SA(0, 0), Abase, cvA[0]); PG8_STAGE(PG8_SA(0, 1), Abase, cvA[1]);
    if (wr == 1) PG8_BAR;
    PG8_WAIT_V(2); PG8_BAR;
    PG8_STAGE(PG8_SB(1, 0), cB + kstep, voffB); PG8_STAGE(PG8_SA(1, 0), Abase + kstep, cvA[0]); PG8_STAGE(PG8_SB(1, 1), cB + hstep + kstep, voffB);
    PG8_WAIT_V(6); PG8_BAR;
    for (;;) {
        const bool has_next = S.next(ui + 1, nxt);
        const char* nB = cB;
        if (has_next) nB = S.b_base(nxt);
#pragma unroll 1
        for (int t = 0; t < nt; t += 2) {
            const bool last = (t == nt - 2);
            const char* a1 = Abase + (size_t)(t + 1) * kstep;
            const char* a2 = last ? Abase : Abase + (size_t)(t + 2) * kstep; const char* b2 = last ? nB : cB + (size_t)(t + 2) * kstep;
            const char* a3 = a2 + kstep; const char* b3 = b2 + kstep;
            if constexpr (Sched::PREF) { if (last && has_next) { int t2 = tid; asm volatile("" : "+v"(t2)); int R0, C0, R1, C1; stage_rc(t2 * 16, R0, C0); stage_rc(t2 * 16 + 8192, R1, C1); S.a_pref(nxt, R0, R1, pf); } }
            PG8_LDB(B0, 0, 0); PG8_LDB(B1, 0, 1); PG8_SCHED; PG8_LDA(At, 0, 0); PG8_STAGE(PG8_SA(1, 1), a1, cvA[1]);
            PG8_WAIT_V(8); PG8_WAIT_L(0); PG8_BAR; PG8_MMA(0, 0, At, B0); PG8_MMA(0, 1, At, B1); PG8_BAR; PG8_SCHED;
            if (last && has_next) {
                int t2 = tid; asm volatile("" : "+v"(t2));
                int R0, C0, R1, C1; stage_rc(t2 * 16, R0, C0); stage_rc(t2 * 16 + 8192, R1, C1);
                if constexpr (Sched::PREF) { asm volatile("s_waitcnt vmcnt(2)" : "+v"(pf[0]), "+v"(pf[1]), "+v"(pf[2]), "+v"(pf[3]) :: "memory"); S.a_offs_pf(pf, C0, C1, cvA); }
                else S.a_offs(nxt, R0, C0, R1, C1, cvA); }
            PG8_LDA(At, 0, 1); PG8_STAGE(PG8_SB(0, 0), b2, voffB); PG8_STAGE(PG8_SB(0, 1), b2 + hstep, voffB); PG8_STAGE(PG8_SA(0, 0), a2, cvA[0]);
            PG8_WAIT_V(8); PG8_WAIT_L(0); PG8_BAR; PG8_MMA(1, 0, At, B0); PG8_MMA(1, 1, At, B1); PG8_BAR; PG8_SCHED;
            PG8_LDB(B0, 1, 0); PG8_LDB(B1, 1, 1); PG8_SCHED; PG8_LDA(At, 1, 0); PG8_STAGE(PG8_SA(0, 1), a2, cvA[1]);
            PG8_WAIT_V(8); PG8_WAIT_L(0); PG8_BAR; PG8_MMA(0, 0, At, B0); PG8_MMA(0, 1, At, B1); PG8_BAR; PG8_SCHED;
            PG8_LDA(At, 1, 1); PG8_STAGE(PG8_SB(1, 0), b3, voffB); PG8_STAGE(PG8_SB(1, 1), b3 + hstep, voffB); PG8_STAGE(PG8_SA(1, 0), a3, cvA[0]);
            PG8_WAIT_V(8); PG8_WAIT_L(0); PG8_BAR; PG8_MMA(1, 0, At, B0); PG8_MMA(1, 1, At, B1); PG8_BAR; PG8_SCHED;
        }
        if constexpr (ALIGN_EPI) { if (wr == 0) PG8_BAR; }
        { int t2 = tid; asm volatile("" : "+v"(t2)); const int w2 = __builtin_amdgcn_readfirstlane(t2 >> 6), l2 = t2 & 63;
          if constexpr (FP8 && SCW == 0) {
#pragma unroll
              for (int a = 0; a < 2; ++a)
#pragma unroll
                  for (int b = 0; b < 2; ++b)
#pragma unroll
                      for (int m = 0; m < 4; ++m)
#pragma unroll
                          for (int n = 0; n < 2; ++n) acc[a][b][m][n] = acc[a][b][m][n] * (1.0f / 256.0f); }
          E(acc, cur, w2 >> 2, w2 & 3, l2 & 15, l2 >> 4); }
        if (!has_next) break;
#pragma unroll
        for (int a = 0; a < 2; ++a)
#pragma unroll
            for (int b = 0; b < 2; ++b)
#pragma unroll
                for (int m = 0; m < 4; ++m)
#pragma unroll
                    for (int n = 0; n < 2; ++n) { float z0, z1, z2, z3; asm volatile("v_mov_b32 %0, 0\n\tv_mov_b32 %1, 0\n\tv_mov_b32 %2, 0\n\tv_mov_b32 %3, 0" : "=v"(z0), "=v"(z1), "=v"(z2), "=v"(z3)); acc[a][b][m][n] = (f32x4){z0, z1, z2, z3}; }
        cur = nxt; cB = nB; ++ui;
        if constexpr (ALIGN_EPI) { if (wr == 1) PG8_BAR; }
    }
    PG8_WAIT_V(0);
    if constexpr (!ALIGN_EPI) { if (wr == 0) PG8_BAR; }
    PG8_BAR;
#undef PG8_SA
#undef PG8_SB
#undef PG8_SBR
#undef PG8_STAGE
#undef PG8_LDA
#undef PG8_LDB
#undef PG8_MMA
#undef PG8_CAT
#undef PG8_L16
#undef PG8_WAIT_V
#undef PG8_WAIT_L
#undef PG8_BAR
#undef PG8_SCHED
}
}
namespace attn_body {
using bf16=__hip_bfloat16;
using bf16x8=__attribute__((ext_vector_type(8)))short;
using s16x4=__attribute__((ext_vector_type(4)))short;
using f32x16=__attribute__((ext_vector_type(16)))float;
using u32x4=__attribute__((ext_vector_type(4)))unsigned;
typedef float f32x4a __attribute__((ext_vector_type(4)));
constexpr int SEQ=4096,D=64,DM=5632;
constexpr int OPITCH=2048;
constexpr int NW=8,QBLK=32,QB=QBLK*NW,KVBLK=64,NQB=SEQ/QB;
__device__ __forceinline__ int crow(int r,int hi){return (r&3)+8*(r>>2)+4*hi;}
#define SBAR() __builtin_amdgcn_sched_barrier(0)
__device__ __forceinline__ void cmask(f32x16&p0,f32x16&p1,int jb,int qrel,int hi){
  const float NEG=-INFINITY; int kb=64*jb+4*hi;
  #pragma unroll
  for(int r=0;r<16;++r){int kv=kb+(r&3)+8*(r>>2); if(kv>qrel)p0[r]=NEG; if(kv+32>qrel)p1[r]=NEG;}
}
__device__ __forceinline__ void cmask_strict(f32x16&p0,f32x16&p1,int jb,int qrel,int hi){
  const float NEG=-INFINITY; int kb=64*jb+4*hi;
  #pragma unroll
  for(int r=0;r<16;++r){int kv=kb+(r&3)+8*(r>>2); if(kv>=qrel)p0[r]=NEG; if(kv+32>=qrel)p1[r]=NEG;}
}

constexpr int NSLOT=3, SLOTB=8192;
constexpr int LDS_K=0, LDS_V=NSLOT*SLOTB, LDS_WS=2*NSLOT*SLOTB, LDS_OST=LDS_WS+NW*64*4, LDS_CK=LDS_OST+NW*4096, LDS_BYTES=LDS_CK+(SEQ+64)*4;
constexpr float C2=0.125f*1.4426950408889634f;
constexpr float WIN_T=40.0f;
__device__ __forceinline__ void glds16(const void*gsrc,unsigned lds_dst){unsigned keep;
  asm volatile("s_mov_b32 %0, m0\n\ts_mov_b32 m0, %2\n\ts_nop 0\n\tglobal_load_lds_dwordx4 %1, off\n\ts_mov_b32 m0, %0":"=&s"(keep):"v"(gsrc),"s"(lds_dst):"memory");}
__device__ __forceinline__ float max3f(float a,float b,float c){float r;asm("v_max3_f32 %0, %1, %2, %3":"=v"(r):"v"(a),"v"(b),"v"(c));return r;}
__device__ __forceinline__ float max2f(float a,float b){float r;asm("v_max_f32_e32 %0, %1, %2":"=v"(r):"v"(a),"v"(b));return r;}
__device__ __forceinline__ float fadd_s(float a,float b){float r;asm("v_add_f32_e32 %0, %1, %2":"=v"(r):"v"(a),"v"(b));return r;}
__device__ __forceinline__ float fsub_s(float a,float b){float r;asm("v_sub_f32_e32 %0, %1, %2":"=v"(r):"v"(a),"v"(b));return r;}
typedef float f32x2_t __attribute__((ext_vector_type(2))); typedef __bf16 bf16x2_t __attribute__((ext_vector_type(2)));
__device__ __forceinline__ unsigned cvtpk_s(float lo,float hi){f32x2_t v={lo,hi};bf16x2_t b=__builtin_convertvector(v,bf16x2_t);return __builtin_bit_cast(unsigned,b);}
#define WAIT_BAR(N) asm volatile("s_waitcnt vmcnt(" #N ") lgkmcnt(0)\n\ts_barrier":::"memory")

typedef __attribute__((address_space(3))) const char* lds_cptr;
typedef short v4i16_t __attribute__((ext_vector_type(4)));
__device__ __forceinline__ void kload8(bf16x8*kf,lds_cptr kp){
  kf[0]=*(const __attribute__((address_space(3))) bf16x8*)(kp);      kf[1]=*(const __attribute__((address_space(3))) bf16x8*)(kp+512);
  kf[2]=*(const __attribute__((address_space(3))) bf16x8*)(kp+2048); kf[3]=*(const __attribute__((address_space(3))) bf16x8*)(kp+2560);
  kf[4]=*(const __attribute__((address_space(3))) bf16x8*)(kp+4096); kf[5]=*(const __attribute__((address_space(3))) bf16x8*)(kp+4608);
  kf[6]=*(const __attribute__((address_space(3))) bf16x8*)(kp+6144); kf[7]=*(const __attribute__((address_space(3))) bf16x8*)(kp+6656);
}
__device__ __forceinline__ void kload2(bf16x8*kf,lds_cptr kp,int j){ kf[2*j]=*(const __attribute__((address_space(3))) bf16x8*)(kp+j*2048); kf[2*j+1]=*(const __attribute__((address_space(3))) bf16x8*)(kp+j*2048+512); }
__device__ __forceinline__ s16x4 vtr(lds_cptr p){ return __builtin_bit_cast(s16x4,__builtin_amdgcn_ds_read_tr16_b64_v4i16((__attribute__((address_space(3))) v4i16_t*)p)); }
__device__ __forceinline__ float rowmax(const f32x16&p0,const f32x16&p1){
  float a=max3f(p0[0],p0[1],p1[0]),b=max3f(p0[2],p0[3],p1[1]);a=max3f(a,p1[2],p1[3]);
  #pragma unroll
  for(int r=4;r<16;r+=4){a=max3f(a,p0[r],p0[r+1]);b=max3f(b,p0[r+2],p0[r+3]);a=max3f(a,p1[r],p1[r+1]);b=max3f(b,p1[r+2],p1[r+3]);}
  const float m=max2f(a,b);
  auto rr=__builtin_amdgcn_permlane32_swap(__float_as_uint(m),__float_as_uint(m),false,false);
  return max2f(__uint_as_float(rr[0]),__uint_as_float(rr[1]));
}
__device__ __forceinline__ void pv(f32x16*o,int vb,bf16x8 pa0,bf16x8 pa1,bf16x8 pa2,bf16x8 pa3){
  #pragma unroll
  for(int d0=0;d0<2;++d0){s16x4 lo[4],hi[4];
    #pragma unroll
    for(int ks=0;ks<4;++ks){
      asm volatile("ds_read_b64_tr_b16 %0,%1 offset:%c2":"=&v"(lo[ks]):"v"(vb),"i"(d0*4096+ks*1024):"memory");
      asm volatile("ds_read_b64_tr_b16 %0,%1 offset:%c2":"=&v"(hi[ks]):"v"(vb),"i"(d0*4096+ks*1024+512):"memory");}
    asm volatile("s_waitcnt lgkmcnt(0)":::"memory");SBAR();
    #define PK(k) (bf16x8){lo[k][0],lo[k][1],lo[k][2],lo[k][3],hi[k][0],hi[k][1],hi[k][2],hi[k][3]}
    o[d0]=__builtin_amdgcn_mfma_f32_32x32x16_bf16(pa0,PK(0),o[d0],0,0,0);
    o[d0]=__builtin_amdgcn_mfma_f32_32x32x16_bf16(pa1,PK(1),o[d0],0,0,0);
    o[d0]=__builtin_amdgcn_mfma_f32_32x32x16_bf16(pa2,PK(2),o[d0],0,0,0);
    o[d0]=__builtin_amdgcn_mfma_f32_32x32x16_bf16(pa3,PK(3),o[d0],0,0,0);
    #undef PK
  }
}
constexpr float O_SCALE=4.0f;
typedef unsigned u32x2_t __attribute__((ext_vector_type(2)));
__device__ __forceinline__ u32x2_t cvt8_fp8(const u32x4 v){
  const float a0=__uint_as_float(v.x<<16)*O_SCALE,a1=__uint_as_float(v.x&0xffff0000u)*O_SCALE,a2=__uint_as_float(v.y<<16)*O_SCALE,a3=__uint_as_float(v.y&0xffff0000u)*O_SCALE;
  const float a4=__uint_as_float(v.z<<16)*O_SCALE,a5=__uint_as_float(v.z&0xffff0000u)*O_SCALE,a6=__uint_as_float(v.w<<16)*O_SCALE,a7=__uint_as_float(v.w&0xffff0000u)*O_SCALE;
  int p=(int)v.x,q=(int)v.y; p=__builtin_amdgcn_cvt_pk_fp8_f32(a0,a1,p,false); p=__builtin_amdgcn_cvt_pk_fp8_f32(a2,a3,p,true); q=__builtin_amdgcn_cvt_pk_fp8_f32(a4,a5,q,false); q=__builtin_amdgcn_cvt_pk_fp8_f32(a6,a7,q,true);
  return (u32x2_t){(unsigned)p,(unsigned)q}; }
#define ATTN_STORE8(p,v) (*(__attribute__((address_space(1))) u32x2_t*)(p)=cvt8_fp8(v))

template<int THRL> __device__ __forceinline__ void fox_unit(int b,int qb,const bf16*Qh,const bf16*__restrict__ Kh_,const bf16*__restrict__ Vh_,unsigned char*Oh,const float*__restrict__ cumh,const float*__restrict__ cendh,char*shm,const int tid_in){
  int tid=tid_in;
  asm volatile("":"+s"(Qh),"+s"(Kh_),"+s"(Vh_),"+s"(Oh),"+s"(cumh),"+s"(cendh),"+v"(tid));
  const int lane=tid&63,r32=lane&31,hi=lane>>5; const int wid=__builtin_amdgcn_readfirstlane(tid>>6);
  const long rowbase=(long)b*SEQ; const int q0=qb*QB;
  const bf16*Qw=Qh+(rowbase+q0+wid*QBLK)*DM;
  const int NTfull=(q0+QB)/KVBLK; int t_lo;
  const bool ckld=tid*8<NTfull*KVBLK; f32x4a cka,ckc; if(ckld){ cka=*(const __attribute__((address_space(1))) f32x4a*)(cumh+tid*8); ckc=*(const __attribute__((address_space(1))) f32x4a*)(cumh+tid*8+4); }
  { const float c0=*(const __attribute__((address_space(1))) float*)(cumh+q0); bool far=false;
    if(lane<NTfull) far=(c0-*(const __attribute__((address_space(1))) float*)(cendh+lane))<-WIN_T;
    t_lo=__builtin_amdgcn_readfirstlane((int)__popcll(__ballot(far)))&~1; if(t_lo>NTfull-4)t_lo=NTfull-4; }
  const bf16*Kh=Kh_+(rowbase+(long)t_lo*KVBLK)*DM,*Vh=Vh_+(rowbase+(long)t_lo*KVBLK)*DM;
  const unsigned lds0=(unsigned)(uintptr_t)shm;
  float*wsf=(float*)(shm+LDS_WS)+wid*64;
  const lds_cptr shm3=(lds_cptr)shm;
  if(ckld){ __attribute__((address_space(3))) f32x4a* dst=(__attribute__((address_space(3))) f32x4a*)(shm3+LDS_CK+tid*32); dst[0]=cka; dst[1]=ckc; }
  const float cq_l=*(const __attribute__((address_space(1))) float*)(cumh+q0+wid*QBLK+r32);
  const bf16*ksrc=Kh+(long)lane*DM+wid*8;
  const bf16*vsrc=Vh+(long)(16*(wid&3)+(lane>>2))*DM+(wid>>2)*32+(lane&3)*8;
  const unsigned kdst=lds0+LDS_K+wid*1024, vdst=lds0+LDS_V+wid*1024;
  #define DMA_K(t,slot) glds16(ksrc+(long)(t)*KVBLK*DM,(unsigned)__builtin_amdgcn_readfirstlane(kdst+(slot)))
  #define DMA_V(t,slot) glds16(vsrc+(long)(t)*KVBLK*DM,(unsigned)__builtin_amdgcn_readfirstlane(vdst+(slot)))
  const int vb0=(int)(lds0+LDS_V)+((lane>>4)&1)*32+(lane&3)*8+(4*hi+((lane&15)>>2))*64;
  bf16x8 kf[8];
  const lds_cptr kp0=shm3+LDS_K+hi*1024+r32*16; const lds_cptr vp0=shm3+LDS_V+((lane>>4)&1)*32+(lane&3)*8+(4*hi+((lane&15)>>2))*64;
  const lds_cptr ckp0=shm3+LDS_CK+t_lo*(KVBLK*4)+hi*16;
  const int NT=NTfull-t_lo;
  DMA_K(0,0);DMA_V(0,0);DMA_K(1,SLOTB);
  bf16x8 qr[4];
  #pragma unroll
  for(int d0=0;d0<4;++d0)qr[d0]=*(const __attribute__((address_space(1))) bf16x8*)(&Qw[(long)r32*DM+d0*16+hi*8]);
  float mhat=0.f,l_reg=0.f,cbase=cq_l;f32x16 o[2];o[0]=f32x16{};o[1]=f32x16{};
  const int qrel=wid*QBLK+r32;
  #define CKG(tt,g) (*(const __attribute__((address_space(3))) f32x4a*)(ckp0+(tt)*256+(g)*32))
  #define CINIT(X0,X1,tt) do{ _Pragma("unroll") for(int g_=0;g_<4;++g_){ const f32x4a a_=CKG(tt,g_), c_=CKG(tt,g_+4); \
      X0[4*g_]=cbase-a_.x; X0[4*g_+1]=cbase-a_.y; X0[4*g_+2]=cbase-a_.z; X0[4*g_+3]=cbase-a_.w; \
      X1[4*g_]=cbase-c_.x; X1[4*g_+1]=cbase-c_.y; X1[4*g_+2]=cbase-c_.z; X1[4*g_+3]=cbase-c_.w; } }while(0)
  #define CMASK(P0,P1,t) do{int jb_=(t)-(NT-4); if(jb_>=0)cmask(P0,P1,jb_,qrel,hi);}while(0)
  bool resc=false;
  #define START(P0,P1) do{ const float rm=rowmax(P0,P1); resc=false; \
    { const float dl=rm; mhat=fadd_s(mhat,dl); cbase=cq_l-mhat; \
      _Pragma("unroll") for(int r=0;r<16;++r){P0[r]=fsub_s(P0[r],dl);P1[r]=fsub_s(P1[r],dl);} } \
    _Pragma("unroll") for(int r=0;r<16;++r)P0[r]=__builtin_amdgcn_exp2f(P0[r]); }while(0)
  #define RESC() do{ if(resc){ asm volatile("s_waitcnt lgkmcnt(0)":::"memory"); \
      _Pragma("unroll") for(int d_=0;d_<2;++d_) _Pragma("unroll") for(int r=0;r<16;++r)o[d_][r]*=wsf[crow(r,hi)]; } }while(0)
  f32x16 pA0,pA1,pB0,pB1;
  int sl_prev=0,sl_cur=0,sl_next=SLOTB;
  #define ROT() do{sl_prev=sl_cur;sl_cur=sl_next;sl_next=(sl_next==(NSLOT-1)*SLOTB)?0:sl_next+SLOTB;}while(0)
  DMA_K(2,2*SLOTB);
  WAIT_BAR(3);
  CINIT(pA0,pA1,0);
  { kload8(kf,kp0);
    #pragma unroll
    for(int d0=0;d0<4;++d0){ pA0=__builtin_amdgcn_mfma_f32_32x32x16_bf16(kf[2*d0],qr[d0],pA0,0,0,0); pA1=__builtin_amdgcn_mfma_f32_32x32x16_bf16(kf[2*d0+1],qr[d0],pA1,0,0,0); } }
  asm volatile("s_nop 15\n\ts_nop 7":"+v"(pA0),"+v"(pA1));CMASK(pA0,pA1,0);
  START(pA0,pA1);
  _Pragma("unroll") for(int r=0;r<16;++r)pA1[r]=__builtin_amdgcn_exp2f(pA1[r]);
  WAIT_BAR(0);
  DMA_K(3,0);DMA_V(1,SLOTB);
  ROT();
  kload8(kf,kp0+sl_cur);
  WAIT_BAR(2);
  s16x4 vlo[8],vhi[8]; u32x4 pw0,pw1,pw2,pw3;
  #define PKW(P,B) cvtpk_s(P[B],P[B+1])
  #define PAF(k) __builtin_bit_cast(bf16x8,pw##k)
  #define VFR(i) (bf16x8){vlo[i][0],vlo[i][1],vlo[i][2],vlo[i][3],vhi[i][0],vhi[i][1],vhi[i][2],vhi[i][3]}
  #define PIN(x) asm volatile("":"+v"(x))
  #define MX3(a,b,c) __builtin_fmaxf(__builtin_fmaxf((a),(b)),(c))
  #define GAPA(MF,A0,A1,A2,A3,W0,W1,PW) do{ MF; sacc+=A0; sacc+=A1; sacc+=A2; sacc+=A3; PIN(sacc); W0; W1; PIN(PW); SBAR(); }while(0)
  #define EX(v) __builtin_amdgcn_exp2f(v)
  #define GAPB(MF,X,B) do{ MF; X[B]=EX(X[B]); X[B+1]=EX(X[B+1]); X[B+2]=EX(X[B+2]); X[B+3]=EX(X[B+3]); PIN(X); SBAR(); }while(0)
  #define VRD(i) do{ vlo[i]=vtr(vp_+(((i)>>2)*4096+((i)&3)*1024)); vhi[i]=vtr(vp_+(((i)>>2)*4096+((i)&3)*1024+512)); }while(0)
  #define KRD(G,j) do{ if(G){ kload2(kf,kp0+sl_next,j); SBAR(); } }while(0)
  #define CKL(P0,P1,t,g_) do{ const f32x4a a_=CKG((t)+1,g_), c_=CKG((t)+1,(g_)+4); P0[4*(g_)]=a_.x;P0[4*(g_)+1]=a_.y;P0[4*(g_)+2]=a_.z;P0[4*(g_)+3]=a_.w; P1[4*(g_)]=c_.x;P1[4*(g_)+1]=c_.y;P1[4*(g_)+2]=c_.z;P1[4*(g_)+3]=c_.w; }while(0)
  #define CKS(P0,P1,g_) do{ P0[4*(g_)]=cbase-P0[4*(g_)];P0[4*(g_)+1]=cbase-P0[4*(g_)+1];P0[4*(g_)+2]=cbase-P0[4*(g_)+2];P0[4*(g_)+3]=cbase-P0[4*(g_)+3]; \
      P1[4*(g_)]=cbase-P1[4*(g_)];P1[4*(g_)+1]=cbase-P1[4*(g_)+1];P1[4*(g_)+2]=cbase-P1[4*(g_)+2];P1[4*(g_)+3]=cbase-P1[4*(g_)+3]; }while(0)
  #define STEP(C0,C1,P0,P1,t,GK,GV,GL) do{ SBAR(); \
    const lds_cptr vp_=vp0+sl_prev; \
    CINIT(C0,C1,t); \
    VRD(0); SBAR(); float sacc=(P0[0]+P0[1]); \
    GAPA(C0=__builtin_amdgcn_mfma_f32_32x32x16_bf16(kf[0],qr[0],C0,0,0,0), P0[2],P0[3],P0[4],P0[5],     pw0[0]=PKW(P0,0), pw0[1]=PKW(P0,2), pw0); \
    VRD(4); SBAR(); GAPA(C1=__builtin_amdgcn_mfma_f32_32x32x16_bf16(kf[1],qr[0],C1,0,0,0), P0[6],P0[7],P0[8],P0[9],     pw0[2]=PKW(P0,4), pw0[3]=PKW(P0,6), pw0); \
    VRD(1); SBAR(); GAPA(C0=__builtin_amdgcn_mfma_f32_32x32x16_bf16(kf[2],qr[1],C0,0,0,0),   P0[10],P0[11],P0[12],P0[13], pw1[0]=PKW(P0,8), pw1[1]=PKW(P0,10), pw1); \
    VRD(5); SBAR(); GAPA(C1=__builtin_amdgcn_mfma_f32_32x32x16_bf16(kf[3],qr[1],C1,0,0,0),   P0[14],P0[15],P1[0],P1[1],   pw1[2]=PKW(P0,12),pw1[3]=PKW(P0,14), pw1); \
    VRD(2); SBAR(); GAPA(C0=__builtin_amdgcn_mfma_f32_32x32x16_bf16(kf[4],qr[2],C0,0,0,0),   P1[2],P1[3],P1[4],P1[5],     pw2[0]=PKW(P1,0), pw2[1]=PKW(P1,2), pw2); \
    VRD(6); SBAR(); GAPA(C1=__builtin_amdgcn_mfma_f32_32x32x16_bf16(kf[5],qr[2],C1,0,0,0),   P1[6],P1[7],P1[8],P1[9],     pw2[2]=PKW(P1,4), pw2[3]=PKW(P1,6), pw2); \
    VRD(3); SBAR(); GAPA(C0=__builtin_amdgcn_mfma_f32_32x32x16_bf16(kf[6],qr[3],C0,0,0,0),   P1[10],P1[11],P1[12],P1[13], pw3[0]=PKW(P1,8), pw3[1]=PKW(P1,10), pw3); \
    VRD(7); SBAR(); GAPA(C1=__builtin_amdgcn_mfma_f32_32x32x16_bf16(kf[7],qr[3],C1,0,0,0),   P1[14],P1[15],0.f,0.f,       pw3[2]=PKW(P1,12),pw3[3]=PKW(P1,14), pw3); \
    l_reg+=sacc; \
    if(GK){DMA_K((t)+3,sl_cur);} if(GV){DMA_V((t)+1,sl_next);} \
    CMASK(C0,C1,t); \
    { float a=MX3(C0[0],C0[1],C1[0]),b=MX3(C0[2],C0[3],C1[1]); a=MX3(a,C1[2],C1[3]); \
      _Pragma("unroll") for(int r=4;r<16;r+=4){a=MX3(a,C0[r],C0[r+1]);b=MX3(b,C0[r+2],C0[r+3]);a=MX3(a,C1[r],C1[r+1]);b=MX3(b,C1[r+2],C1[r+3]);} \
      float rm=__builtin_fmaxf(a,b); { auto rr=__builtin_amdgcn_permlane32_swap(__float_as_uint(rm),__float_as_uint(rm),false,false); rm=__builtin_fmaxf(__uint_as_float(rr[0]),__uint_as_float(rr[1])); } \
      resc=false; \
      if(__builtin_expect(__any(rm>(float)THRL),0)){ const float dl=__builtin_fmaxf(rm,0.f); mhat+=dl; cbase=cq_l-mhat; \
        _Pragma("unroll") for(int r=0;r<16;++r){C0[r]-=dl;C1[r]-=dl;} \
        const float f=__builtin_amdgcn_exp2f(-dl); l_reg*=f; if(hi==0)wsf[r32]=f; resc=true; } } \
    SBAR(); \
    GAPB(o[0]=__builtin_amdgcn_mfma_f32_32x32x16_bf16(PAF(0),VFR(0),o[0],0,0,0), C0,0); \
    GAPB(o[1]=__builtin_amdgcn_mfma_f32_32x32x16_bf16(PAF(0),VFR(4),o[1],0,0,0), C0,4); \
    KRD(GL,0); GAPB(o[0]=__builtin_amdgcn_mfma_f32_32x32x16_bf16(PAF(1),VFR(1),o[0],0,0,0), C0,8); \
    KRD(GL,1); GAPB(o[1]=__builtin_amdgcn_mfma_f32_32x32x16_bf16(PAF(1),VFR(5),o[1],0,0,0), C0,12); \
    KRD(GL,2); GAPB(o[0]=__builtin_amdgcn_mfma_f32_32x32x16_bf16(PAF(2),VFR(2),o[0],0,0,0), C1,0); \
    KRD(GL,3); GAPB(o[1]=__builtin_amdgcn_mfma_f32_32x32x16_bf16(PAF(2),VFR(6),o[1],0,0,0), C1,4); \
    GAPB(o[0]=__builtin_amdgcn_mfma_f32_32x32x16_bf16(PAF(3),VFR(3),o[0],0,0,0), C1,8); \
    GAPB(o[1]=__builtin_amdgcn_mfma_f32_32x32x16_bf16(PAF(3),VFR(7),o[1],0,0,0), C1,12); \
    }while(0)
  int t=1;
  #undef CMASK
  #define CMASK(P0,P1,t) do{}while(0)
  for(;t+5<NT;t+=2){
    STEP(pB0,pB1,pA0,pA1,t,true,true,true);     WAIT_BAR(2); RESC(); ROT();
    STEP(pA0,pA1,pB0,pB1,t+1,true,true,true);   WAIT_BAR(2); RESC(); ROT();
  }
  #undef CMASK
  #define CMASK(P0,P1,t) do{int jb_=(t)-(NT-4); if(jb_>=0)cmask(P0,P1,jb_,qrel,hi);}while(0)
  #define ENDW(tt) do{ if((tt)+3<NT){WAIT_BAR(2);} else if((tt)+2<NT){WAIT_BAR(1);} else {WAIT_BAR(0);} }while(0)
  for(;t+1<NT;t+=2){
    STEP(pB0,pB1,pA0,pA1,t,(t+3<NT),(t+1<NT),(t+1<NT));       ENDW(t);   RESC(); ROT();
    STEP(pA0,pA1,pB0,pB1,t+1,(t+4<NT),(t+2<NT),(t+2<NT));     ENDW(t+1); RESC(); ROT();
  }
  STEP(pB0,pB1,pA0,pA1,NT-1,false,false,false); RESC();
  { float sacc=pB0[0]+pB0[1]; _Pragma("unroll") for(int r=2;r<16;++r)sacc+=pB0[r]; _Pragma("unroll") for(int r=0;r<16;++r)sacc+=pB1[r]; l_reg+=sacc;
    pw0=(u32x4){PKW(pB0,0),PKW(pB0,2),PKW(pB0,4),PKW(pB0,6)};pw1=(u32x4){PKW(pB0,8),PKW(pB0,10),PKW(pB0,12),PKW(pB0,14)};pw2=(u32x4){PKW(pB1,0),PKW(pB1,2),PKW(pB1,4),PKW(pB1,6)};pw3=(u32x4){PKW(pB1,8),PKW(pB1,10),PKW(pB1,12),PKW(pB1,14)};
    SBAR(); pv(o,vb0+sl_cur,PAF(0),PAF(1),PAF(2),PAF(3)); }
  #undef PKW
  #undef PAF
  #undef VFR
  #undef PIN
  #undef MX3
  #undef GAPA
  #undef GAPB
  #undef EX
  #undef VRD
  #undef KRD
  #undef CKL
  #undef CKS
  #undef STEP
  #undef ENDW
  {auto rr=__builtin_amdgcn_permlane32_swap(__float_as_uint(l_reg),__float_as_uint(l_reg),false,false);l_reg=__uint_as_float(rr[0])+__uint_as_float(rr[1]);}
  if(hi==0)wsf[32+r32]=l_reg;asm volatile("s_waitcnt lgkmcnt(0)":::"memory");
  float rli[16];
  #pragma unroll
  for(int r=0;r<16;++r)rli[r]=__builtin_amdgcn_rcpf(wsf[32+crow(r,hi)]);
  unsigned char*Ow=Oh+(rowbase+q0+wid*QBLK)*OPITCH;
  { bf16*stg=(bf16*)(shm+LDS_OST)+wid*2048;
    #pragma unroll
    for(int r=0;r<16;++r){const int orow=crow(r,hi);
      #pragma unroll
      for(int d0=0;d0<2;++d0)stg[orow*64+d0*32+r32]=__float2bfloat16(o[d0][r]*rli[r]);}
    asm volatile("s_waitcnt lgkmcnt(0)":::"memory");
    #pragma unroll
    for(int i=0;i<4;++i){const int row=i*8+(lane>>3),ch=lane&7; const u32x4 v=*(const u32x4*)(stg+row*64+ch*8); ATTN_STORE8(Ow+(long)row*OPITCH+ch*8,v);} }
  asm volatile("s_waitcnt lgkmcnt(0)\n\ts_barrier":::"memory");
  #undef DMA_K
  #undef DMA_V
  #undef CMASK
  #undef CINIT
  #undef CKG
  #undef START
  #undef RESC
  #undef ROT
}

__device__ __forceinline__ void sb_unit(int b,int qb,const bf16*Qh,const bf16*__restrict__ Kh_,const bf16*__restrict__ Vh_,unsigned char*Oh,char*shm,const int tid_in){
  int tid=tid_in;
  asm volatile("":"+s"(Qh),"+s"(Kh_),"+s"(Vh_),"+s"(Oh),"+v"(tid));
  const int lane=tid&63,r32=lane&31,hi=lane>>5; const int wid=__builtin_amdgcn_readfirstlane(tid>>6);
  const long rowbase=(long)b*SEQ; const int q0=qb*QB;
  const bf16*Qw=Qh+(rowbase+q0+wid*QBLK)*DM;
  const bf16*Kh=Kh_+rowbase*DM,*Vh=Vh_+rowbase*DM;
  const unsigned lds0=(unsigned)(uintptr_t)shm;
  const lds_cptr shm3=(lds_cptr)shm;
  const bf16*ksrc=Kh+(long)lane*DM+wid*8;
  const bf16*vsrc=Vh+(long)(16*(wid&3)+(lane>>2))*DM+(wid>>2)*32+(lane&3)*8;
  const unsigned kdst=lds0+LDS_K+wid*1024, vdst=lds0+LDS_V+wid*1024;
  #define DMA_K(t,slot) glds16(ksrc+(long)(t)*KVBLK*DM,(unsigned)__builtin_amdgcn_readfirstlane(kdst+(slot)))
  #define DMA_V(t,slot) glds16(vsrc+(long)(t)*KVBLK*DM,(unsigned)__builtin_amdgcn_readfirstlane(vdst+(slot)))
  const int vb0=(int)(lds0+LDS_V)+((lane>>4)&1)*32+(lane&3)*8+(4*hi+((lane&15)>>2))*64;
  const lds_cptr kp0=shm3+LDS_K+hi*1024+r32*16;
  const int NT=(q0+QB)/KVBLK;
  DMA_K(NT-1,0);DMA_V(NT-1,0);
  bf16x8 qr[4];
  #pragma unroll
  for(int d0=0;d0<4;++d0)qr[d0]=*(const __attribute__((address_space(1))) bf16x8*)(&Qw[(long)r32*DM+d0*16+hi*8]);
  f32x16 o[2];o[0]=f32x16{};o[1]=f32x16{};
  float one=1.0f; asm volatile("":"+v"(one));
  float R=one;
  const int qrel=wid*QBLK+r32;
  constexpr float SB_DONE=1.0995116e12f;
  __attribute__((address_space(3))) unsigned* dflag=(__attribute__((address_space(3))) unsigned*)(shm3+LDS_WS);
  for(int it=0;it<NT;++it){
    const int t=NT-1-it; const int slot=(it&1)*SLOTB;
    if(lane==0) dflag[(it&1)*NW+wid]=__all(R>SB_DONE)?1u:0u;
    asm volatile("s_waitcnt vmcnt(0) lgkmcnt(0)\n\ts_barrier":::"memory");
    { const u32x4 f0=*(const __attribute__((address_space(3))) u32x4*)(dflag+(it&1)*NW), f1=*(const __attribute__((address_space(3))) u32x4*)(dflag+(it&1)*NW+4);
      if((f0.x&f0.y&f0.z&f0.w&f1.x&f1.y&f1.z&f1.w)!=0u) break; }
    if(it+1<NT){ DMA_K(t-1,slot^SLOTB); DMA_V(t-1,slot^SLOTB); }
    if(it<4 && 64*(3-it)>wid*QBLK+QBLK-1) continue;
    bf16x8 kf[8]; kload8(kf,kp0+slot);
    f32x16 p0=f32x16{},p1=f32x16{};
    #pragma unroll
    for(int d0=0;d0<4;++d0){ p0=__builtin_amdgcn_mfma_f32_32x32x16_bf16(kf[2*d0],qr[d0],p0,0,0,0); p1=__builtin_amdgcn_mfma_f32_32x32x16_bf16(kf[2*d0+1],qr[d0],p1,0,0,0); }
    if(it<4) cmask_strict(p0,p1,3-it,qrel,hi);
    #pragma unroll
    for(int r=0;r<16;++r){ p0[r]=__builtin_amdgcn_exp2f(p0[r]); p1[r]=__builtin_amdgcn_exp2f(p1[r]); }
    float c=R;
    #pragma unroll
    for(int g=7;g>=0;--g){
      float u0,u1,u2,u3;
      if(g<4){u0=p0[4*g];u1=p0[4*g+1];u2=p0[4*g+2];u3=p0[4*g+3];}else{u0=p1[4*(g-4)];u1=p1[4*(g-4)+1];u2=p1[4*(g-4)+2];u3=p1[4*(g-4)+3];}
      const float s3=one+u3, s2=(one+u2)*s3, s1=(one+u1)*s2, s0=(one+u0)*s1;
      const unsigned s0b=__float_as_uint(s0);
      auto rr=__builtin_amdgcn_permlane32_swap(s0b,s0b,false,false);
      const float gpartner=__uint_as_float(rr[0]==s0b?rr[1]:rr[0]);
      const float carry=hi?c:c*gpartner;
      const float a0=u0*__builtin_amdgcn_rcpf(s0*carry), a1=u1*__builtin_amdgcn_rcpf(s1*carry), a2=u2*__builtin_amdgcn_rcpf(s2*carry), a3=u3*__builtin_amdgcn_rcpf(s3*carry);
      if(g<4){p0[4*g]=a0;p0[4*g+1]=a1;p0[4*g+2]=a2;p0[4*g+3]=a3;}else{p1[4*(g-4)]=a0;p1[4*(g-4)+1]=a1;p1[4*(g-4)+2]=a2;p1[4*(g-4)+3]=a3;}
      c=c*(s0*gpartner);
    }
    R=c;
    u32x4 pw0,pw1,pw2,pw3;
    #define PKW(P,B) cvtpk_s(P[B],P[B+1])
    pw0=(u32x4){PKW(p0,0),PKW(p0,2),PKW(p0,4),PKW(p0,6)};pw1=(u32x4){PKW(p0,8),PKW(p0,10),PKW(p0,12),PKW(p0,14)};pw2=(u32x4){PKW(p1,0),PKW(p1,2),PKW(p1,4),PKW(p1,6)};pw3=(u32x4){PKW(p1,8),PKW(p1,10),PKW(p1,12),PKW(p1,14)};
    #undef PKW
    pv(o,vb0+slot,__builtin_bit_cast(bf16x8,pw0),__builtin_bit_cast(bf16x8,pw1),__builtin_bit_cast(bf16x8,pw2),__builtin_bit_cast(bf16x8,pw3));
  }
  unsigned char*Ow=Oh+(rowbase+q0+wid*QBLK)*OPITCH;
  { bf16*stg=(bf16*)(shm+LDS_OST)+wid*2048;
    #pragma unroll
    for(int r=0;r<16;++r){const int orow=crow(r,hi);
      #pragma unroll
      for(int d0=0;d0<2;++d0)stg[orow*64+d0*32+r32]=__float2bfloat16(o[d0][r]);}
    asm volatile("s_waitcnt lgkmcnt(0)":::"memory");
    #pragma unroll
    for(int i=0;i<4;++i){const int row=i*8+(lane>>3),ch=lane&7; const u32x4 v=*(const u32x4*)(stg+row*64+ch*8); ATTN_STORE8(Ow+(long)row*OPITCH+ch*8,v);} }
  asm volatile("s_waitcnt vmcnt(0) lgkmcnt(0)\n\ts_barrier":::"memory");
  #undef DMA_K
  #undef DMA_V
}
#undef SBAR
#undef WAIT_BAR
}
#ifndef MK_IN_FP8
#define MK_IN_FP8 1
#endif
#ifndef MK_GU_FP8
#define MK_GU_FP8 1
#endif
#ifndef MK_PER_PHASE
#define MK_PER_PHASE 0
#endif
constexpr int NWAVES = 8, NTHR = NWAVES * 64;
constexpr int BATCH = 4, SEQ = 4096, T = BATCH * SEQ, D = 2048, DEPTH = 2, D6 = 6 * D;
constexpr int MIXC = 5648;
constexpr int NPROJ = 5632, NPROJ_PAD = 5888;
constexpr int C_QSB = 0, C_KSB = 512, C_VSB = 1024, C_QFX = 1536, C_KFX = 2560, C_VFX = 3584, C_GA = 4608, C_GG = 5120;
constexpr int O_SB = 0, O_FX = 512, O_CV = 1536;
constexpr int NEXP = 32, DEXP = 1024, NFH = 16, CONVW = 31, CCH = 512;
constexpr int LISTCAP = 16384, HIDROWS = 2 * T + NEXP * 256;
constexpr float LN_EPS = 1e-5f, ALPHA = 1.4142135623730951f, LOG2E = 1.4426950408889634f;
constexpr int NPHASE = 2 + 8 * DEPTH;

constexpr size_t MiB = 1u << 20;
constexpr size_t WS_CTL = 0, CTL_ZERO_BYTES = 1 * MiB;
constexpr size_t WS_MOD = 1 * MiB, WS_RWT = 2 * MiB, WS_FLOG = 3 * MiB, WS_CUM = 4 * MiB, WS_ROUTE = 5 * MiB, WS_LIST = 6 * MiB;
constexpr size_t WS_WIN = 8 * MiB, WS_WOUT = 54 * MiB, WS_WGU = 70 * MiB, WS_WDN = 582 * MiB;
constexpr size_t WS_H = 838 * MiB, WS_PROJ = 902 * MiB, WS_MIX = 1078 * MiB, WS_Z = 1142 * MiB, WS_X1 = 1270 * MiB, WS_X2 = 1398 * MiB, WS_HID = 1526 * MiB, WS_Y = 1606 * MiB, WS_END = 1766 * MiB;
constexpr size_t WS_H8 = WS_Z + 64 * MiB;
static_assert(WS_WIN + (size_t)DEPTH * NPROJ_PAD * D * 2 <= WS_WOUT && WS_WOUT + (size_t)DEPTH * D * D * 2 <= WS_WGU && WS_WGU + (size_t)DEPTH * NEXP * 2048 * 2048 * 2 <= WS_WDN && WS_WDN + (size_t)DEPTH * NEXP * 2048 * 1024 * 2 <= WS_H, "ws map (weights)");
static_assert(WS_H + (size_t)T * D * 2 <= WS_PROJ && WS_PROJ + (size_t)T * NPROJ * 2 <= WS_MIX && WS_MIX + (size_t)T * D * 2 <= WS_Z && WS_Z + (size_t)T * D * 4 <= WS_X1 && WS_X1 + (size_t)T * D * 4 <= WS_X2 && WS_X2 + (size_t)T * D * 4 <= WS_HID, "ws map (act)");
static_assert(WS_HID + (size_t)HIDROWS * DEXP * 2 <= WS_Y && WS_Y + (size_t)HIDROWS * D * 2 <= WS_END, "ws map (moe)");
constexpr int CW_TMO = 0, CW_CODE = 1, CW_BAR = 4096, CW_CNT = 8192, CW_Q = 12288, CW_XC = 12288 + 4 * 64;

constexpr int RING_OFF = 0, RING_BYTES = 131072;
constexpr int LDSCTL_OFF = 8 * 128 * 33 * 4  , MISC_OFF = LDSCTL_OFF + 320, MOE_OFF = LDSCTL_OFF + 1024;
constexpr int LDS_BYTES = 147456;

#define GAS __attribute__((address_space(1)))
#define LAS __attribute__((address_space(3)))
typedef unsigned short bf16;
typedef unsigned v4u __attribute__((ext_vector_type(4)));
typedef unsigned v2u __attribute__((ext_vector_type(2)));
typedef float f32x4 __attribute__((ext_vector_type(4)));
typedef float f32x2 __attribute__((ext_vector_type(2)));
typedef short bf16x8 __attribute__((ext_vector_type(8)));
typedef GAS unsigned gu32;
#define RLX_AGENT __ATOMIC_RELAXED, __HIP_MEMORY_SCOPE_AGENT
#define LDS_WAIT() asm volatile("s_waitcnt lgkmcnt(0)" ::: "memory")
#define VM_WAIT() asm volatile("s_waitcnt vmcnt(0)" ::: "memory")
__device__ __forceinline__ unsigned f2bf(float f) { unsigned u = __builtin_bit_cast(unsigned, f); return (u + 0x7fffu + ((u >> 16) & 1u)) >> 16; }
__device__ __forceinline__ unsigned pk2(float lo, float hi) { return f2bf(lo) | (f2bf(hi) << 16); }
__device__ __forceinline__ float bf2f(unsigned short b) { return __uint_as_float(((unsigned)b) << 16); }
__device__ __forceinline__ float clamp_fp8(float x) { return __builtin_amdgcn_fmed3f(x, -448.f, 448.f); }
__device__ __forceinline__ unsigned pk4_fp8(float a, float b, float c, float d) { int p = __float_as_int(a)  ; p = __builtin_amdgcn_cvt_pk_fp8_f32(a, b, p, false); p = __builtin_amdgcn_cvt_pk_fp8_f32(c, d, p, true); return (unsigned)p; }
constexpr float S_W8 = 64.f, S_A8 = 4.f;
constexpr int SC_W8 = 127 - 4, SC_A8 = 127 - 4;

#define XB_TMO      128
#define XB_XCNT(j)  (256  + 64 * (j))
#define XB_XSUB(j)  (1280 + 64 * (j))
#define XB_XGEN(j)  (2304 + 64 * (j))
#define XB_TOP      3328
#define XB_TOPGEN   3392
#define XCD_BAR_WORDS 3456
#define XB_SPIN_CAP (1u << 18)
__device__ __forceinline__ unsigned xb_ld(gu32* p)              { return __hip_atomic_load(p, __ATOMIC_RELAXED, __HIP_MEMORY_SCOPE_AGENT); }
__device__ __forceinline__ unsigned xb_add(gu32* p, unsigned v) { return __hip_atomic_fetch_add(p, v, __ATOMIC_RELAXED, __HIP_MEMORY_SCOPE_AGENT); }
__device__ __forceinline__ unsigned xb_xcc_id() { return (unsigned)__builtin_amdgcn_s_getreg((3 << 11) | 20) & 0xFu; }
#define XB_SPIN(cond, bar) do { unsigned _sp = 0; while (cond) { __builtin_amdgcn_s_sleep(1); \
    if ((++_sp & 255u) == 0u) { if (xb_ld(&(bar)[XB_TMO])) break; if (_sp > XB_SPIN_CAP) { (void)xb_add(&(bar)[XB_TMO], 1u); break; } } } } while (0)
struct XcdBarrier { gu32* bar; unsigned x; volatile LAS unsigned* st; };
__device__ __forceinline__ XcdBarrier xcd_barrier_post(gu32* bar, volatile LAS unsigned* st, bool leader) {
    XcdBarrier b; b.bar = bar; b.x = xb_xcc_id(); b.st = st;
    if (leader) (void)xb_add(&bar[XB_XCNT(b.x)], 1u);
    return b;
}
__device__ __forceinline__ void xcd_barrier_complete(gu32* bar, unsigned x, unsigned& nloc, unsigned& nx) {
    const unsigned G = gridDim.x * gridDim.y * gridDim.z;
    unsigned sum, cnt, mine, sp = 0u;
    for (;;) {
        sum = 0u; cnt = 0u; mine = 0u;
#pragma unroll 1
        for (unsigned j = 0; j < 16; ++j) { const unsigned c = xb_ld(&bar[XB_XCNT(j)]); sum += c; cnt += (c > 0u) ? 1u : 0u; mine = (j == x) ? c : mine; }
        if (sum == G) break;
        __builtin_amdgcn_s_sleep(1);
        if ((++sp & 255u) == 0u) { if (xb_ld(&bar[XB_TMO])) break; if (sp > XB_SPIN_CAP) { (void)xb_add(&bar[XB_TMO], 1u); break; } }
    }
    nloc = mine > 0u ? mine : 1u; nx = cnt > 0u ? cnt : 1u;
}
__device__ __forceinline__ void xcd_barrier(const XcdBarrier& b, const bool leader) {
    asm volatile("s_waitcnt vmcnt(0)" ::: "memory");
    __syncthreads();
    if (leader) {
        gu32* bar = b.bar;
        __builtin_amdgcn_s_waitcnt(0);
        unsigned nloc = b.st[0], nx = b.st[1];
        if (nloc == 0u) { xcd_barrier_complete(bar, b.x, nloc, nx); b.st[0] = nloc; b.st[1] = nx; }
        const unsigned old = xb_add(&bar[XB_XSUB(b.x)], 1u);
        const unsigned gen = old / nloc;
        if (old + 1u == (gen + 1u) * nloc) {
            __builtin_amdgcn_fence(__ATOMIC_RELEASE, "agent");
            asm volatile("s_waitcnt vmcnt(0)" ::: "memory");
            const unsigned og = xb_add(&bar[XB_TOP], 1u);
            const unsigned tg = og / nx;
            if (og + 1u == (tg + 1u) * nx) xb_add(&bar[XB_TOPGEN], 1u);
            else XB_SPIN(xb_ld(&bar[XB_TOPGEN]) == tg, bar);
            __builtin_amdgcn_fence(__ATOMIC_ACQUIRE, "agent");
            xb_add(&bar[XB_XGEN(b.x)], 1u);
            asm volatile("s_waitcnt vmcnt(0)" ::: "memory");
        } else {
            XB_SPIN(xb_ld(&bar[XB_XGEN(b.x)]) == gen, bar);
            __builtin_amdgcn_fence(__ATOMIC_ACQUIRE, "agent");
            asm volatile("s_waitcnt vmcnt(0)" ::: "memory");
        }
    }
    __syncthreads();
}

struct Args {
    const float *x, *c, *ada_w, *ada_b, *w_in, *b_forget, *conv_w, *conv_b, *conv_ln_g, *conv_ln_b, *w_out, *ln1_g, *ln1_b, *r1_w, *r1_b, *r2_w, *r2_b, *w_gate, *w_up, *w_down, *ln2_g, *ln2_b;
    float* out; unsigned char* ws; int ph_lo, ph_hi, dup, pad;
};
typedef const __attribute__((address_space(4))) Args* ArgsP;
__device__ __forceinline__ ArgsP kargs() { ArgsP p = (ArgsP)__builtin_amdgcn_kernarg_segment_ptr(); asm volatile("" : "+s"(p)); return p; }

#define dpp_f(v, ctrl) __int_as_float(__builtin_amdgcn_update_dpp(0, __float_as_int(v), (ctrl), 0xF, 0xF, false))
__device__ __forceinline__ float wave_sum(float v) {
    v += dpp_f(v, 0xB1); v += dpp_f(v, 0x4E); v += dpp_f(v, 0x141); v += dpp_f(v, 0x140);
    const float r0 = __int_as_float(__builtin_amdgcn_readlane(__float_as_int(v), 0)), r1 = __int_as_float(__builtin_amdgcn_readlane(__float_as_int(v), 16));
    const float r2 = __int_as_float(__builtin_amdgcn_readlane(__float_as_int(v), 32)), r3 = __int_as_float(__builtin_amdgcn_readlane(__float_as_int(v), 48));
    return (r0 + r1) + (r2 + r3);
}
__device__ __forceinline__ float silu_f(float v) { return v / (1.0f + __expf(-v)); }

#define LDS_BARRIER() do { asm volatile("s_waitcnt lgkmcnt(0)" ::: "memory"); __builtin_amdgcn_s_barrier(); asm volatile("" ::: "memory"); } while (0)
struct TItem { const float* W; unsigned char* WT; int ldw, k0, n0, ldk, dst_row0, rstride, f8; };
__device__ __forceinline__ TItem titem_decode(ArgsP A, int it) {
    constexpr int I_A = 16 * 18, I_B = 16 * 4, I_O = 16 * 8;
    constexpr int PER_L = I_A + I_B + I_O;
    unsigned char* ws = A->ws; TItem t; const int l = it / PER_L; int r = it % PER_L; t.rstride = 1; t.f8 = 0;
    if (r < I_A + I_B) { t.W = A->w_in + (size_t)l * D * MIXC; t.ldw = MIXC; t.WT = ws + WS_WIN + (size_t)l * NPROJ_PAD * D * (MK_IN_FP8 ? 1 : 2); t.ldk = D; t.f8 = MK_IN_FP8;
        if (r < I_A) { const int kb = r / 18, nb = r % 18; t.k0 = 128 * kb; t.n0 = 256 * nb; t.dst_row0 = 256 * nb; }
        else { r -= I_A; const int kb = r / 4, nb = r % 4; t.k0 = 128 * kb; t.n0 = 4624 + 256 * nb; t.dst_row0 = 4608 + 256 * nb; }
        return t; }
    r -= I_A + I_B;
    { const int kb = r / 8, nb = r % 8; t.W = A->w_out + (size_t)l * D * D; t.ldw = D; t.WT = ws + WS_WOUT + (size_t)l * D * D; t.ldk = D; t.k0 = 128 * kb; t.n0 = 256 * nb; t.dst_row0 = 256 * nb; t.f8 = 1; return t; }
}
constexpr int N_XTILE = 3 * NEXP * 64;
__device__ __forceinline__ TItem titem_decode_expert(ArgsP A, int l, int r) {
    constexpr int I_G = NEXP * 64, I_U = NEXP * 64;
    unsigned char* ws = A->ws; TItem t; t.rstride = 1; t.f8 = 1;
    if (r < I_G + I_U) { const int up = r >= I_G; if (up) r -= I_G; const int e = r / 64, q = r % 64, kb = q / 4, nb = q % 4;
        t.W = (up ? A->w_up : A->w_gate) + ((size_t)l * NEXP + e) * D * DEXP; t.ldw = DEXP; t.WT = ws + WS_WGU + ((size_t)l * NEXP + e) * 2048 * 2048 * (MK_GU_FP8 ? 1 : 2); t.ldk = D;
        t.k0 = 128 * kb; t.n0 = 256 * nb; t.dst_row0 = 512 * nb + up; t.rstride = 2; t.f8 = MK_GU_FP8; return t; }
    r -= I_G + I_U;
    { const int e = r / 64, q = r % 64, kb = q / 8, nb = q % 8; t.W = A->w_down + ((size_t)l * NEXP + e) * DEXP * D; t.ldw = D; t.WT = ws + WS_WDN + ((size_t)l * NEXP + e) * 2048 * 1024; t.ldk = DEXP;
      t.k0 = 128 * kb; t.n0 = 256 * nb; t.dst_row0 = 256 * nb; return t; }
}
static_assert(MK_IN_FP8 && MK_GU_FP8, "the register-transposing weight copy writes fp8 rows only");
__device__ __forceinline__ void titem_load(const TItem& t, f32x4 (&v)[16], int lane, int wave) {
    const float* p = t.W + (size_t)(t.k0 + 16 * (lane >> 3)) * t.ldw + t.n0 + 32 * wave + 4 * (lane & 7); const size_t st = (size_t)t.ldw;
#pragma unroll
    for (int i = 0; i < 16; ++i) v[i] = __builtin_nontemporal_load((const GAS f32x4*)(p + i * st));
}
__device__ __forceinline__ void titem_store(const TItem& t, const f32x4 (&v)[16], LAS float*, int lane, int wave) {
    unsigned char* op = t.WT + (size_t)(t.dst_row0 + (32 * wave + 4 * (lane & 7)) * t.rstride) * t.ldk + t.k0 + 16 * (lane >> 3); const size_t ost = (size_t)t.rstride * t.ldk;
#pragma unroll
    for (int c = 0; c < 4; ++c) { v4u o;
        o.x = pk4_fp8(v[0][c] * S_W8, v[1][c] * S_W8, v[2][c] * S_W8, v[3][c] * S_W8); o.y = pk4_fp8(v[4][c] * S_W8, v[5][c] * S_W8, v[6][c] * S_W8, v[7][c] * S_W8);
        o.z = pk4_fp8(v[8][c] * S_W8, v[9][c] * S_W8, v[10][c] * S_W8, v[11][c] * S_W8); o.w = pk4_fp8(v[12][c] * S_W8, v[13][c] * S_W8, v[14][c] * S_W8, v[15][c] * S_W8);
        __builtin_nontemporal_store(o, (GAS v4u*)(op + c * ost)); }
}
__device__ __forceinline__ void convert_claim(ArgsP A, int l, int n, LAS unsigned char* lds, int tid, int wave) {
    LAS unsigned* xw = (LAS unsigned*)(lds + MISC_OFF + 96);
    if (tid == 0) *xw = __hip_atomic_fetch_add((gu32*)(A->ws + WS_CTL) + CW_XC + l * 64, (unsigned)n, RLX_AGENT);
    __syncthreads();
    const int x0 = __builtin_amdgcn_readfirstlane((int)*xw);
    __syncthreads();
    if (n == 4 && x0 + 4 <= N_XTILE) {
        int l2; asm volatile("v_mbcnt_lo_u32_b32 %0, -1, 0\n\tv_mbcnt_hi_u32_b32 %0, -1, %0" : "=v"(l2));
        f32x4 va[16], vb[16];
        const TItem t0 = titem_decode_expert(A, l, x0), t1 = titem_decode_expert(A, l, x0 + 1), t2 = titem_decode_expert(A, l, x0 + 2), t3 = titem_decode_expert(A, l, x0 + 3);
        titem_load(t0, va, l2, wave); titem_load(t1, vb, l2, wave);
        titem_store(t0, va, (LAS float*)nullptr, l2, wave); titem_load(t2, va, l2, wave);
        titem_store(t1, vb, (LAS float*)nullptr, l2, wave); titem_load(t3, vb, l2, wave);
        titem_store(t2, va, (LAS float*)nullptr, l2, wave); titem_store(t3, vb, (LAS float*)nullptr, l2, wave);
        return; }
#pragma unroll 1
    for (int j = 0; j < n; ++j) { if (x0 + j >= N_XTILE) break;
        int l2; asm volatile("v_mbcnt_lo_u32_b32 %0, -1, 0\n\tv_mbcnt_hi_u32_b32 %0, -1, %0" : "=v"(l2));
        const TItem t = titem_decode_expert(A, l, x0 + j); f32x4 v[16]; titem_load(t, v, l2, wave); titem_store(t, v, (LAS float*)(lds + RING_OFF), l2, wave); }
}
__device__ __forceinline__ void p0_prologue(ArgsP A, LAS unsigned char* lds, int vcu, int G, int tid, int lane, int wave) {
    unsigned char* ws = A->ws;
    {
        LAS float* sT = (LAS float*)(lds + RING_OFF);
        LAS float* red = (LAS float*)(lds + RING_OFF + 32768);
        for (int i = tid; i < BATCH * D; i += NTHR) { const int b = i / D, k = i % D; sT[k * 4 + b] = silu_f(A->c[i]); }
        __syncthreads();
        float* mod = (float*)(ws + WS_MOD);
        for (int it = vcu; it < 256; it += G) {
            const int l = it / 128, col0 = (it % 128) * 96;
            float acc[8];
#pragma unroll
            for (int j = 0; j < 8; ++j) acc[j] = 0.f;
            if (lane < 48) {
                const float* wp = A->ada_w + ((size_t)l * D + wave * 256) * D6 + col0 + 2 * lane;
#pragma unroll 16
                for (int k = 0; k < 256; ++k) { const f32x2 w = __builtin_nontemporal_load((const GAS f32x2*)(wp + (size_t)k * D6)); const f32x4 s = *(const LAS f32x4*)(sT + (wave * 256 + k) * 4);
                    acc[0] += s.x * w.x; acc[1] += s.x * w.y; acc[2] += s.y * w.x; acc[3] += s.y * w.y; acc[4] += s.z * w.x; acc[5] += s.z * w.y; acc[6] += s.w * w.x; acc[7] += s.w * w.y; }
#pragma unroll
                for (int j = 0; j < 8; ++j) red[(wave * 48 + lane) * 8 + j] = acc[j];
            }
            __syncthreads();
            if (tid < 384) { const int b = tid / 96, cc = tid % 96, ln = cc >> 1, comp = cc & 1; float s = 0.f;
#pragma unroll
                for (int w = 0; w < 8; ++w) s += red[(w * 48 + ln) * 8 + b * 2 + comp];
                mod[((size_t)l * BATCH + b) * D6 + col0 + cc] = s + A->ada_b[(size_t)l * D6 + col0 + cc]; }
            __syncthreads();
        }
    }
    {
        LAS float* scr = (LAS float*)(lds + RING_OFF);
        constexpr int NITEM = DEPTH * (16 * 18 + 16 * 4 + 16 * 8);
        int it = vcu;
        if (it < NITEM) { TItem cur = titem_decode(A, it); f32x4 va[16], vb[16]; titem_load(cur, va, lane, wave);
#pragma unroll 1
            for (;;) {
                const int itn = it + G; const bool hn = itn < NITEM; TItem nx = cur; if (hn) { nx = titem_decode(A, itn); titem_load(nx, vb, lane, wave); }
                titem_store(cur, va, scr, lane, wave);
                if (!hn) break;
                const int itn2 = itn + G; const bool hn2 = itn2 < NITEM; if (hn2) { cur = titem_decode(A, itn2); titem_load(cur, va, lane, wave); }
                titem_store(nx, vb, scr, lane, wave);
                if (!hn2) break;
                it = itn2;
            } }
        for (int i = vcu * NTHR + tid; i < DEPTH * 16 * D; i += G * NTHR) { const int l = i / (16 * D), k = (i / 16) % D, n = i % 16;
            const float w = A->w_in[((size_t)l * D + k) * MIXC + 4608 + n];
            if (MK_IN_FP8) (ws + WS_WIN)[((size_t)l * NPROJ_PAD + NPROJ + n) * D + k] = (unsigned char)(pk4_fp8(w * S_W8, 0.f, 0.f, 0.f) & 0xffu);
            else ((bf16*)(ws + WS_WIN))[((size_t)l * NPROJ_PAD + NPROJ + n) * D + k] = (bf16)f2bf(w); }
        bf16* rwt = (bf16*)(ws + WS_RWT);
        for (int i = vcu * NTHR + tid; i < DEPTH * 48 * D; i += G * NTHR) {
            const int l = i / (48 * D), n = (i / D) % 48, k = i % D; float w = 0.f;
            if (n < 4) w = A->r1_w[((size_t)l * D + k) * 4 + n]; else if (n < 36) { const int g = (n - 4) >> 3, e = (n - 4) & 7; w = A->r2_w[(((size_t)l * 4 + g) * D + k) * 8 + e]; }
            const unsigned hi = f2bf(w); const float rem = w - __uint_as_float(hi << 16);
            rwt[((size_t)l * 96 + n) * D + k] = (bf16)hi; rwt[((size_t)l * 96 + 48 + n) * D + k] = (bf16)f2bf(rem);
        }
    }
}

__device__ __forceinline__ void row_stats(const f32x4 (&v)[8], float& mean, float& rstd) {
    float s = 0.f;
#pragma unroll
    for (int j = 0; j < 8; ++j) s += (v[j].x + v[j].y) + (v[j].z + v[j].w);
    mean = wave_sum(s) * (1.f / D); float s2 = 0.f;
#pragma unroll
    for (int j = 0; j < 8; ++j) { const f32x4 d = v[j] - mean; s2 += (d.x * d.x + d.y * d.y) + (d.z * d.z + d.w * d.w); }
    rstd = 1.f / sqrtf(wave_sum(s2) * (1.f / D) + LN_EPS);
}
__device__ __forceinline__ void ld_row16(const bf16* row, int lane, v2u (&r)[8]) {
#pragma unroll
    for (int j = 0; j < 8; ++j) r[j] = *((const GAS v2u*)row + lane + 64 * j);
}
__device__ __forceinline__ void ld_row32(const float* row, int lane, f32x4 (&r)[8]) {
#pragma unroll
    for (int j = 0; j < 8; ++j) r[j] = *((const GAS f32x4*)row + lane + 64 * j);
}
__device__ __forceinline__ f32x4 bf4(const v2u a) { f32x4 o; o.x = __uint_as_float(a.x << 16); o.y = __uint_as_float(a.x & 0xffff0000u); o.z = __uint_as_float(a.y << 16); o.w = __uint_as_float(a.y & 0xffff0000u); return o; }
__device__ __forceinline__ void st_row16(bf16* row, int lane, const f32x4 (&v)[8]) {
    GAS v2u* o8 = (GAS v2u*)row + lane;
#pragma unroll
    for (int j = 0; j < 8; ++j) { v2u w; w.x = pk2(v[j].x, v[j].y); w.y = pk2(v[j].z, v[j].w); o8[64 * j] = w; }
}
__device__ __forceinline__ void ln_mod_store(const f32x4 (&v)[8], const LAS float* sc, const LAS float* sh, bf16* orow, int lane, unsigned char* o8row = nullptr) {
    float mean, rstd; row_stats(v, mean, rstd);
    GAS v2u* o8 = (GAS v2u*)orow + lane; GAS unsigned* q8 = (GAS unsigned*)o8row + lane;
#pragma unroll
    for (int j = 0; j < 8; ++j) { const f32x4 s = *((const LAS f32x4*)sc + lane + 64 * j), b = *((const LAS f32x4*)sh + lane + 64 * j);
        const f32x4 h = (v[j] - mean) * rstd * (1.0f + s) + b; if (orow) { v2u w; w.x = pk2(h.x, h.y); w.y = pk2(h.z, h.w); o8[64 * j] = w; }
        if (o8row) q8[64 * j] = pk4_fp8(clamp_fp8(h.x * S_A8), clamp_fp8(h.y * S_A8), clamp_fp8(h.z * S_A8), clamp_fp8(h.w * S_A8)); }
}
template <int N> __device__ __forceinline__ void stage_vecs(LAS float* dst, const float* const (&src)[N], int tid) {
    asm volatile("" : "+v"(tid)); const unsigned off = (unsigned)tid * 16u; f32x4 v[N];
#pragma unroll
    for (int k = 0; k < N; ++k) v[k] = *(const GAS f32x4*)((const GAS char*)src[k] + off);
#pragma unroll
    for (int k = 0; k < N; ++k) ((LAS f32x4*)(dst + k * D))[tid] = v[k];
}
__device__ __forceinline__ void stage_vec(LAS float* dst, const float* src, int tid) { asm volatile("" : "+v"(tid)); ((LAS f32x4*)dst)[tid] = *((const GAS f32x4*)src + tid); }

__device__ __forceinline__ void p1_ln0(ArgsP A, LAS unsigned char* lds, int vcu, int G, int tid, int lane, int wave) {
    const float* mod = (const float*)(A->ws + WS_MOD); bf16* H = (bf16*)(A->ws + WS_H); LAS float* vec = (LAS float*)(lds + RING_OFF);
    for (int ch = vcu; ch < T / 64; ch += G) { const int r0 = ch * 64 + wave * 8, b = r0 / SEQ;
        { const float* const sv[2] = {mod + (size_t)b * D6 + D, mod + (size_t)b * D6}; stage_vecs<2>(vec, sv, tid); }
        f32x4 va[8], vb[8]; ld_row32(A->x + (size_t)r0 * D, lane, va);
        __syncthreads();
#pragma unroll 1
        for (int rr = 0; rr < 8; rr += 2) {
            ld_row32(A->x + (size_t)(r0 + rr + 1) * D, lane, vb);
            if (MK_IN_FP8) ln_mod_store(va, vec, vec + D, (bf16*)nullptr, lane, (unsigned char*)H + (size_t)(r0 + rr) * D); else ln_mod_store(va, vec, vec + D, H + (size_t)(r0 + rr) * D, lane);
            if (rr + 2 < 8) ld_row32(A->x + (size_t)(r0 + rr + 2) * D, lane, va);
            if (MK_IN_FP8) ln_mod_store(vb, vec, vec + D, (bf16*)nullptr, lane, (unsigned char*)H + (size_t)(r0 + rr + 1) * D); else ln_mod_store(vb, vec, vec + D, H + (size_t)(r0 + rr + 1) * D, lane);
        }
        __syncthreads();
    }
}

struct StaticSched {
    static constexpr bool TAILS = false; static constexpr bool PREF = false;
    int nM, nN, nwg, G, c, K; const char* Bt;
    __device__ __forceinline__ void init(int M, int N, int K_, int G_, int c_, const void* Bt_) { nM = M / 256; nN = N / 256; nwg = nM * nN; G = G_; c = c_; K = K_; Bt = (const char*)Bt_; }
    __device__ __forceinline__ bool next(int i, pg8::Unit& u) const {
        const long L = (long)i * G + c; if (L >= nwg) return false;
        int wgid = (int)L; { const int q = nwg / 8, r = nwg % 8, xcd = wgid % 8, off = wgid / 8; wgid = (xcd < r ? xcd * (q + 1) : r * (q + 1) + (xcd - r) * q) + off; }
        const int nig = 8 * nN, gid = wgid / nig, fm = gid * 8, gsz = (nM - fm) < 8 ? (nM - fm) : 8;
        u.pm = fm + ((wgid % nig) % gsz); u.pn = (wgid % nig) / gsz; u.e = 0; u.rows = 256; return true;
    }
    __device__ __forceinline__ const char* b_base(const pg8::Unit& u) const { return Bt + (size_t)u.pn * 256 * K * 2; }
    __device__ __forceinline__ void a_offs(const pg8::Unit& u, int R0, int C0, int R1, int C1, unsigned (&o)[2][2]) const {
#pragma unroll
        for (int h = 0; h < 2; ++h) { o[h][0] = (unsigned)((u.pm * 256 + h * 128 + R0) * K + C0) * 2u; o[h][1] = (unsigned)((u.pm * 256 + h * 128 + R1) * K + C1) * 2u; }
    }
};
template <bool GATHER> struct MoeSched {
    static constexpr bool TAILS = true; static constexpr bool PREF = GATHER;
    const LAS int* tp; const LAS int* cnt; const int* list; int G, c, K; const char* Bt; size_t bstride;
    __device__ __forceinline__ bool next(int i, pg8::Unit& u) const {
        const int L = i * G + c; const int total = tp[NEXP] * 8; if (L >= total) return false;
        const int mtg = L >> 3;
        int ln; asm volatile("v_mbcnt_lo_u32_b32 %0, -1, 0\n\tv_mbcnt_hi_u32_b32 %0, -1, %0" : "=v"(ln));
        const int tv = tp[ln & (NEXP - 1)];
        const int e = __builtin_popcountll(__builtin_amdgcn_ballot_w64(ln >= 1 && ln < NEXP && tv <= mtg));
        u.pm = mtg; u.pn = L & 7; u.e = e; u.rows = cnt[e] - 256 * (mtg - tp[e]); return true;
    }
    __device__ __forceinline__ const char* b_base(const pg8::Unit& u) const { return Bt + (size_t)u.e * bstride + (size_t)u.pn * 256 * K * 2; }
    __device__ __forceinline__ void a_offs(const pg8::Unit& u, int R0, int C0, int R1, int C1, unsigned (&o)[2][2]) const {
        if constexpr (GATHER) {
            const int* lp = list + (size_t)u.e * LISTCAP + 256 * (u.pm - tp[u.e]);
#pragma unroll
            for (int h = 0; h < 2; ++h) { const int i0 = h * 128 + R0, i1 = h * 128 + R1; const int t0 = i0 < u.rows ? lp[i0] : 0, t1 = i1 < u.rows ? lp[i1] : 0;
                o[h][0] = (unsigned)(t0 * K + C0) * 2u; o[h][1] = (unsigned)(t1 * K + C1) * 2u; }
        } else {
#pragma unroll
            for (int h = 0; h < 2; ++h) { o[h][0] = (unsigned)((u.pm * 256 + h * 128 + R0) * K + C0) * 2u; o[h][1] = (unsigned)((u.pm * 256 + h * 128 + R1) * K + C1) * 2u; }
        }
    }
    __device__ __forceinline__ void a_pref(const pg8::Unit& u, int R0, int R1, int (&pf)[4]) const {
        const int rm = u.rows - 1; const unsigned long long la = (unsigned long long)(list + (size_t)u.e * LISTCAP + 256 * (u.pm - tp[u.e]));
        const int* lp = (const int*)(((unsigned long long)(unsigned)__builtin_amdgcn_readfirstlane((int)(la >> 32)) << 32) | (unsigned)__builtin_amdgcn_readfirstlane((int)la));
#pragma unroll
        for (int h = 0; h < 2; ++h) { const int i0 = min(h * 128 + R0, rm) * 4, i1 = min(h * 128 + R1, rm) * 4;
            asm volatile("global_load_dword %0, %1, %2" : "=v"(pf[2 * h]) : "v"(i0), "s"(lp) : "memory");
            asm volatile("global_load_dword %0, %1, %2" : "=v"(pf[2 * h + 1]) : "v"(i1), "s"(lp) : "memory"); }
    }
    __device__ __forceinline__ void a_offs_pf(const int (&pf)[4], int C0, int C1, unsigned (&o)[2][2]) const {
#pragma unroll
        for (int h = 0; h < 2; ++h) { o[h][0] = (unsigned)(pf[2 * h] * K + C0) * 2u; o[h][1] = (unsigned)(pf[2 * h + 1] * K + C1) * 2u; }
    }
};

struct EpiProj {
    static constexpr bool PERM = true;
    bf16* P; float* flog;
    __device__ __forceinline__ void operator()(const pg8::f32x4 (&acc)[2][2][4][2], const pg8::Unit& u, int wr, int wc, int fr, int fq) const {
        const int row0 = u.pm * 256 + wr * 64 + fr;
        if (u.pn == 22) {
            if (wc == 0 && fq < 2) {
#pragma unroll
                for (int ai = 0; ai < 2; ++ai)
#pragma unroll
                    for (int m = 0; m < 4; ++m) { float* p = flog + (size_t)(8 * fq) * T + (row0 + ai * 128 + m * 16);
#pragma unroll
                        for (int n = 0; n < 2; ++n)
#pragma unroll
                            for (int i = 0; i < 4; ++i) p[(size_t)(4 * n + i) * T] = acc[ai][0][m][n][i]; }
            }
            return;
        }
        const float sc = (u.pn < 2 || (u.pn >= 6 && u.pn < 10)) ? attn_body::C2 : 1.0f;
        const int col0 = u.pn * 256 + wc * 32 + 8 * fq;
#pragma unroll
        for (int ai = 0; ai < 2; ++ai)
#pragma unroll
            for (int m = 0; m < 4; ++m) { bf16* rowp = P + (size_t)(row0 + ai * 128 + m * 16) * NPROJ + col0;
#pragma unroll
                for (int bj = 0; bj < 2; ++bj) { const pg8::f32x4 v0 = acc[ai][bj][m][0] * sc, v1 = acc[ai][bj][m][1] * sc; pg8::u32x4 w;
                    w.x = pg8::cvt_pk_bf16(v0[0], v0[1]); w.y = pg8::cvt_pk_bf16(v0[2], v0[3]); w.z = pg8::cvt_pk_bf16(v1[0], v1[1]); w.w = pg8::cvt_pk_bf16(v1[2], v1[3]);
                    *(pg8::u32x4*)(rowp + bj * 128) = w; } }
    }
};
struct EpiZ {
    static constexpr bool PERM = true;
    const float* xin32; const bf16* xin16; const float* gate  ; bf16* Z;
    __device__ __forceinline__ void operator()(const pg8::f32x4 (&acc)[2][2][4][2], const pg8::Unit& u, int wr, int wc, int fr, int fq) const {
        const int col0 = u.pn * 256 + wc * 32 + 8 * fq; const int b = (u.pm * 256) / SEQ; const float* g = gate + (size_t)b * D6;
        pg8::f32x4 gv[2][2];
#pragma unroll
        for (int bj = 0; bj < 2; ++bj)
#pragma unroll
            for (int n = 0; n < 2; ++n) gv[bj][n] = *(const GAS pg8::f32x4*)(g + col0 + bj * 128 + n * 4);
        const size_t off0 = (size_t)(u.pm * 256 + wr * 64 + fr) * D + col0;
#define EPZ_OUT(AI, M, BJ, X0, X1) do { const pg8::f32x4 z0 = (X0) * ALPHA + gv[BJ][0] * acc[AI][BJ][M][0], z1 = (X1) * ALPHA + gv[BJ][1] * acc[AI][BJ][M][1]; pg8::u32x4 w; \
            w.x = pg8::cvt_pk_bf16(z0[0], z0[1]); w.y = pg8::cvt_pk_bf16(z0[2], z0[3]); w.z = pg8::cvt_pk_bf16(z1[0], z1[1]); w.w = pg8::cvt_pk_bf16(z1[2], z1[3]); \
            *(GAS pg8::u32x4*)(Z + off0 + (size_t)((AI) * 128 + (M) * 16) * D + (BJ) * 128) = w; } while (0)
        if (xin32) {
#pragma unroll
            for (int ai = 0; ai < 2; ++ai) { pg8::f32x4 xv[4][2][2];
#pragma unroll
                for (int m = 0; m < 4; ++m)
#pragma unroll
                    for (int bj = 0; bj < 2; ++bj) { const float* p = xin32 + off0 + (size_t)(ai * 128 + m * 16) * D + bj * 128; xv[m][bj][0] = *(const GAS pg8::f32x4*)p; xv[m][bj][1] = *(const GAS pg8::f32x4*)(p + 4); }
#pragma unroll
                for (int m = 0; m < 4; ++m)
#pragma unroll
                    for (int bj = 0; bj < 2; ++bj) EPZ_OUT(ai, m, bj, xv[m][bj][0], xv[m][bj][1]); }
        } else { v4u xr[2][4][2];
#pragma unroll
            for (int ai = 0; ai < 2; ++ai)
#pragma unroll
                for (int m = 0; m < 4; ++m)
#pragma unroll
                    for (int bj = 0; bj < 2; ++bj) xr[ai][m][bj] = *(const GAS v4u*)(xin16 + off0 + (size_t)(ai * 128 + m * 16) * D + bj * 128);
#pragma unroll
            for (int ai = 0; ai < 2; ++ai)
#pragma unroll
                for (int m = 0; m < 4; ++m)
#pragma unroll
                    for (int bj = 0; bj < 2; ++bj) { const v4u r = xr[ai][m][bj]; EPZ_OUT(ai, m, bj, bf4((v2u){r.x, r.y}), bf4((v2u){r.z, r.w})); }
        }
#undef EPZ_OUT
    }
};
struct EpiHid {
    static constexpr bool PERM = true;
    unsigned char* Hd;
    __device__ __forceinline__ void operator()(const pg8::f32x4 (&acc)[2][2][4][2], const pg8::Unit& u, int wr, int wc, int fr, int fq) const {
        const int col0 = u.pn * 128 + wc * 16 + 4 * fq;
#pragma unroll
        for (int ai = 0; ai < 2; ++ai)
#pragma unroll
            for (int m = 0; m < 4; ++m) { unsigned char* rowp = Hd + (size_t)(u.pm * 256 + ai * 128 + wr * 64 + m * 16 + fr) * DEXP + col0;
#pragma unroll
                for (int bj = 0; bj < 2; ++bj) { const pg8::f32x4 a = acc[ai][bj][m][0], b = acc[ai][bj][m][1];
                    const float h0 = a[0] * __builtin_amdgcn_rcpf(1.0f + __builtin_amdgcn_exp2f(-LOG2E * a[0])) * a[1] * S_A8, h1 = a[2] * __builtin_amdgcn_rcpf(1.0f + __builtin_amdgcn_exp2f(-LOG2E * a[2])) * a[3] * S_A8;
                    const float h2 = b[0] * __builtin_amdgcn_rcpf(1.0f + __builtin_amdgcn_exp2f(-LOG2E * b[0])) * b[1] * S_A8, h3 = b[2] * __builtin_amdgcn_rcpf(1.0f + __builtin_amdgcn_exp2f(-LOG2E * b[2])) * b[3] * S_A8;
                    *(GAS unsigned*)(rowp + bj * 64) = pk4_fp8(clamp_fp8(h0), clamp_fp8(h1), clamp_fp8(h2), clamp_fp8(h3)); } }
    }
};
struct EpiY {
    static constexpr bool PERM = true;
    bf16* Y;
    __device__ __forceinline__ void operator()(const pg8::f32x4 (&acc)[2][2][4][2], const pg8::Unit& u, int wr, int wc, int fr, int fq) const {
        const int col0 = u.pn * 256 + wc * 32 + 8 * fq;
#pragma unroll
        for (int ai = 0; ai < 2; ++ai)
#pragma unroll
            for (int m = 0; m < 4; ++m) { bf16* rowp = Y + (size_t)(u.pm * 256 + ai * 128 + wr * 64 + m * 16 + fr) * D + col0;
#pragma unroll
                for (int bj = 0; bj < 2; ++bj) { const pg8::f32x4 v0 = acc[ai][bj][m][0], v1 = acc[ai][bj][m][1]; pg8::u32x4 w;
                    w.x = pg8::cvt_pk_bf16(v0[0], v0[1]); w.y = pg8::cvt_pk_bf16(v0[2], v0[3]); w.z = pg8::cvt_pk_bf16(v1[0], v1[1]); w.w = pg8::cvt_pk_bf16(v1[2], v1[3]);
                    *(pg8::u32x4*)(rowp + bj * 128) = w; } }
    }
};

__device__ __forceinline__ void cum_unit(ArgsP A, int l, int bh, LAS unsigned char* lds, int tid, int lane, int wave) {
    const int b = bh / NFH, h = bh % NFH; const float* flog = (const float*)(A->ws + WS_FLOG); float* cum = (float*)(A->ws + WS_CUM) + (size_t)bh * SEQ;
    const float bf = A->b_forget[l * NFH + h]; LAS float* wt = (LAS float*)(lds + RING_OFF);
    float v[8]; float run = 0.f;
    f32x4 fl[2]; fl[0] = *(const GAS f32x4*)(flog + (size_t)h * T + (size_t)b * SEQ + tid * 8); fl[1] = *(const GAS f32x4*)(flog + (size_t)h * T + (size_t)b * SEQ + tid * 8 + 4);
#pragma unroll
    for (int i = 0; i < 8; ++i) { const float x = fl[i >> 2][i & 3] + bf; const float ls = fminf(x, 0.f) - log1pf(__expf(-fabsf(x))); run += ls * LOG2E; v[i] = run; }
    float inc = run;
#pragma unroll
    for (int o = 1; o < 64; o <<= 1) { const float t = __int_as_float(__builtin_amdgcn_ds_bpermute(((lane - o) & 63) << 2, __float_as_int(inc))); if (lane >= o) inc += t; }
    if (lane == 63) wt[wave] = inc;
    __syncthreads();
    float off = inc - run;
    for (int w = 0; w < wave; ++w) off += wt[w];
#pragma unroll
    for (int i = 0; i < 8; ++i) cum[tid * 8 + i] = v[i] + off;
    if ((tid & 7) == 7) ((float*)(A->ws + WS_MOD + 768 * 1024))[bh * 64 + (tid >> 3)] = v[7] + off;
    __syncthreads();
}
__device__ __forceinline__ void conv_unit(ArgsP A, int l, int unit, LAS unsigned char* lds, int tid, int lane, int wave) {
    constexpr int TC = 32, ROWS = TC + CONVW - 1;
    const int t0 = unit * TC, b = t0 / SEQ, tl0 = t0 % SEQ; const bf16* P = (const bf16*)(A->ws + WS_PROJ); unsigned char* MIX = A->ws + WS_MIX;
    LAS float* part = (LAS float*)(lds + RING_OFF);
    LAS float* stat = part + NWAVES * TC * 2;
    unsigned short ra[ROWS], rg[ROWS];
#pragma unroll
    for (int r = 0; r < ROWS; ++r) { const int tl = tl0 - (CONVW - 1) + r; const bf16* row = P + (size_t)(b * SEQ + (tl < 0 ? 0 : tl)) * NPROJ; ra[r] = row[C_GA + tid]; rg[r] = row[C_GG + tid]; }
    float w[CONVW];
#pragma unroll
    for (int j = 0; j < CONVW; ++j) w[j] = A->conv_w[((size_t)l * CONVW + j) * CCH + tid];
    const float cb = A->conv_b[l * CCH + tid], lg = A->conv_ln_g[l * CCH + tid], lb = A->conv_ln_b[l * CCH + tid];
    float u[ROWS];
#pragma unroll
    for (int r = 0; r < ROWS; ++r) { const int tl = tl0 - (CONVW - 1) + r; const float a = bf2f(ra[r]), g = bf2f(rg[r]); u[r] = (tl >= 0) ? a * __builtin_amdgcn_rcpf(1.0f + __builtin_amdgcn_exp2f(-LOG2E * g)) : 0.f; }
    float y[TC];
#pragma unroll
    for (int tt = 0; tt < TC; ++tt) { float a = cb;
#pragma unroll
        for (int j = 0; j < CONVW; ++j) a += w[j] * u[tt + j];
        y[tt] = a; }
#pragma unroll
    for (int tt = 0; tt < TC; ++tt) { const float s = wave_sum(y[tt]), s2 = wave_sum(y[tt] * y[tt]); if (lane == 0) { part[(wave * TC + tt) * 2] = s; part[(wave * TC + tt) * 2 + 1] = s2; } }
    __syncthreads();
    if (tid < TC) { float s = 0.f, s2 = 0.f;
#pragma unroll
        for (int wv = 0; wv < NWAVES; ++wv) { s += part[(wv * TC + tid) * 2]; s2 += part[(wv * TC + tid) * 2 + 1]; }
        const float mean = s * (1.f / CCH); const float var = fmaxf(s2 * (1.f / CCH) - mean * mean, 0.f); stat[tid * 2] = mean; stat[tid * 2 + 1] = 1.f / sqrtf(var + LN_EPS); }
    __syncthreads();
#pragma unroll
    for (int tt = 0; tt < TC; ++tt) { const float v = (y[tt] - stat[tt * 2]) * stat[tt * 2 + 1] * lg + lb; const float o = v * __builtin_amdgcn_rcpf(1.0f + __builtin_amdgcn_exp2f(-LOG2E * v));
        MIX[(size_t)(t0 + tt) * D + O_CV + tid] = (unsigned char)(__builtin_amdgcn_cvt_pk_fp8_f32(clamp_fp8(o * attn_body::O_SCALE), 0.f, 0, false) & 0xff); }
    __syncthreads();
}

__device__ __forceinline__ void p6_ln_route(ArgsP A, int l, LAS unsigned char* lds, int vcu, int G, int tid, int lane, int wave) {
    unsigned char* ws = A->ws; const bf16* Z = (const bf16*)(ws + WS_Z); bf16* X1 = (bf16*)(ws + WS_X1); bf16* H = (bf16*)(ws + WS_H);
    const float* mod = (const float*)(ws + WS_MOD) + (size_t)l * BATCH * D6; const bf16* rwt = (const bf16*)(ws + WS_RWT) + (size_t)l * 96 * D;
    gu32* cntw = (gu32*)(ws + WS_CTL) + CW_CNT + l * NEXP * 64; int* list = (int*)(ws + WS_LIST); unsigned* rte = (unsigned*)(ws + WS_ROUTE); float* rtw = (float*)(ws + WS_ROUTE + 256 * 1024);
    const float* g1 = A->ln1_g + (size_t)l * D; const float* b1 = A->ln1_b + (size_t)l * D;
    LAS float* lg = (LAS float*)(lds + RING_OFF);
    LAS unsigned* lcnt = (LAS unsigned*)(lds + RING_OFF + 2 * 64 * 48 * 4); LAS unsigned* lbase = lcnt + NEXP;
    LAS float* vec = (LAS float*)(lds + RING_OFF + 32768);
    for (int ch = vcu; ch < T / 64; ch += G) {
        const int r0 = ch * 64, b = r0 / SEQ;
        { const float* const sv[4] = {g1, b1, mod + (size_t)b * D6 + 4 * D, mod + (size_t)b * D6 + 3 * D}; stage_vecs<4>(vec, sv, tid); }
        { const int m0 = r0 + wave * 8; v2u za[8], zb[8]; ld_row16(Z + (size_t)m0 * D, lane, za); ld_row16(Z + (size_t)(m0 + 1) * D, lane, zb);
          __syncthreads();
#define RT_ROW(ZR, RR, NXT) do { f32x4 v[8]; const LAS float* vr = vec; asm volatile("" : "+v"(vr)); \
              _Pragma("unroll") for (int j = 0; j < 8; ++j) v[j] = bf4(ZR[j]); \
              if ((NXT) < 8) ld_row16(Z + (size_t)(m0 + (NXT)) * D, lane, ZR); \
              float mean, rstd; row_stats(v, mean, rstd); \
              _Pragma("unroll") for (int j = 0; j < 8; ++j) { const f32x4 g = *((const LAS f32x4*)vr + lane + 64 * j), bb = *((const LAS f32x4*)(vr + D) + lane + 64 * j); v[j] = (v[j] - mean) * rstd * g + bb; } \
              ln_mod_store(v, vr + 2 * D, vr + 3 * D, H + (size_t)(m0 + (RR)) * D, lane, MK_GU_FP8 ? ws + WS_H8 + (size_t)(m0 + (RR)) * D : (unsigned char*)nullptr); } while (0)
#pragma unroll 1
          for (int rr = 0; rr < 8; rr += 2) { RT_ROW(za, rr, rr + 2); RT_ROW(zb, rr + 1, rr + 3); }
#undef RT_ROW
        }
        VM_WAIT(); __syncthreads();
        { constexpr int KC = 128, PB = KC * 2 + 16  , NROW = 64 + 96, CHB = NROW * PB;
          LAS unsigned char* rbuf = lds + RING_OFF + 32768;
          const int rt = wave & 3, part = wave >> 2, fr = lane & 15, fq = lane >> 4;
          f32x4 acc[3]; acc[0] = acc[1] = acc[2] = (f32x4){0.f, 0.f, 0.f, 0.f};
          v4u pa[5], pb[5];
          constexpr int NCH = D / KC;
#define RT_LOAD(P, c) do { const int cc_ = (c) < NCH ? (c) : NCH - 1; _Pragma("unroll") for (int i = 0; i < 5; ++i) { const int p = tid + 512 * i, row = p >> 4, seg = p & 15; \
              const bf16* src = (row < 64 ? H + (size_t)(r0 + row) * D : rwt + (size_t)(row - 64) * D) + cc_ * KC + seg * 8; P[i] = *(const GAS v4u*)src; } } while (0)
#define RT_PUT(P, b) do { _Pragma("unroll") for (int i = 0; i < 5; ++i) { const int p = tid + 512 * i, row = p >> 4, seg = p & 15; *(LAS v4u*)(rbuf + (b) * CHB + row * PB + seg * 16) = P[i]; } } while (0)
#define RT_COMP(b) do { const LAS unsigned char* hb = rbuf + (b) * CHB + (rt * 16 + fr) * PB + fq * 16; const LAS unsigned char* wb = rbuf + (b) * CHB + (64 + part * 48 + fr) * PB + fq * 16; \
              _Pragma("unroll") for (int j = 0; j < KC / 32; ++j) { const bf16x8 hf = *(const LAS bf16x8*)(hb + j * 64); \
                  _Pragma("unroll") for (int nt = 0; nt < 3; ++nt) { const bf16x8 wf = *(const LAS bf16x8*)(wb + nt * 16 * PB + j * 64); acc[nt] = __builtin_amdgcn_mfma_f32_16x16x32_bf16(wf, hf, acc[nt], 0, 0, 0); } } } while (0)
          __syncthreads();
          RT_LOAD(pa, 0); RT_LOAD(pb, 1); RT_PUT(pa, 0); RT_PUT(pb, 1); RT_LOAD(pa, 2); RT_LOAD(pb, 3); LDS_BARRIER();
#pragma unroll 1
          for (int c = 0; c < NCH; c += 2) {
              RT_COMP(0); LDS_BARRIER(); RT_PUT(pa, 0); RT_LOAD(pa, c + 4);
              RT_COMP(1); LDS_BARRIER(); RT_PUT(pb, 1); RT_LOAD(pb, c + 5);
          }
#undef RT_LOAD
#undef RT_PUT
#undef RT_COMP
#pragma unroll
          for (int nt = 0; nt < 3; ++nt)
#pragma unroll
              for (int i = 0; i < 4; ++i) lg[(part * 64 + rt * 16 + fr) * 48 + nt * 16 + 4 * fq + i] = acc[nt][i]; }
        __syncthreads();
        int ex0 = 0, ex1 = 0; unsigned lr0 = 0u, lr1 = 0u;
        if (tid < NEXP) lcnt[tid] = 0u;
        __syncthreads();
        if (tid < 64) { const int tok = r0 + tid; float L[36];
#pragma unroll
            for (int n = 0; n < 36; ++n) L[n] = lg[tid * 48 + n] + lg[(64 + tid) * 48 + n];
            float l1[4]; int grp = 0; float mx = -INFINITY;
#pragma unroll
            for (int g = 0; g < 4; ++g) { l1[g] = L[g] + A->r1_b[l * 4 + g]; if (l1[g] > mx) { mx = l1[g]; grp = g; } }
            float den = 0.f;
#pragma unroll
            for (int g = 0; g < 4; ++g) den += __expf(l1[g] - mx);
            const float pgrp = 1.0f / den;
            float l2[8]; float m2 = -INFINITY;
#pragma unroll
            for (int e = 0; e < 8; ++e) { float v = 0.f;
#pragma unroll
                for (int g = 0; g < 4; ++g) v = (g == grp) ? L[4 + 8 * g + e] : v;
                l2[e] = v + A->r2_b[(l * 4 + grp) * 8 + e]; m2 = fmaxf(m2, l2[e]); }
            int e0 = 0, e1 = 0; float v0 = -INFINITY, v1 = -INFINITY;
#pragma unroll
            for (int e = 0; e < 8; ++e) { const float v = l2[e]; if (v > v0) { v1 = v0; e1 = e0; v0 = v; e0 = e; } else if (v > v1) { v1 = v; e1 = e; } }
            const float p0 = __expf(v0 - m2), p1 = __expf(v1 - m2); const float w0 = pgrp * p0 / (p0 + p1), w1 = pgrp * p1 / (p0 + p1);
            ex0 = grp * 8 + e0; ex1 = grp * 8 + e1;
            lr0 = __hip_atomic_fetch_add(lcnt + ex0, 1u, __ATOMIC_RELAXED, __HIP_MEMORY_SCOPE_WORKGROUP); lr1 = __hip_atomic_fetch_add(lcnt + ex1, 1u, __ATOMIC_RELAXED, __HIP_MEMORY_SCOPE_WORKGROUP);
            rtw[tok * 2] = w0; rtw[tok * 2 + 1] = w1; }
        __syncthreads();
        if (tid < NEXP) { const unsigned c = lcnt[tid]; unsigned base = 0u; if (c) base = __hip_atomic_fetch_add(cntw + tid * 64, c, RLX_AGENT); lbase[tid] = base; }
        __syncthreads();
        if (tid < 64) { const int tok = r0 + tid; const unsigned s0 = lbase[ex0] + lr0, s1 = lbase[ex1] + lr1;
            list[(size_t)ex0 * LISTCAP + s0] = tok; list[(size_t)ex1 * LISTCAP + s1] = tok;
            rte[tok * 2] = ((unsigned)ex0 << 16) | s0; rte[tok * 2 + 1] = ((unsigned)ex1 << 16) | s1; }
        __syncthreads();
    }
}
__device__ __forceinline__ void moe_table(ArgsP A, int l, LAS unsigned char* lds, int tid) {
    LAS int* tp = (LAS int*)(lds + MOE_OFF); LAS int* cn = tp + 40;
    if (tid < NEXP) { const gu32* cntw = (const gu32*)(A->ws + WS_CTL) + CW_CNT + l * NEXP * 64; cn[tid] = (int)__hip_atomic_load(cntw + tid * 64, RLX_AGENT); }
    __syncthreads();
    if (tid <= NEXP) { int s = 0;
#pragma unroll 1
        for (int j = 0; j < tid; ++j) s += (cn[j] + 255) >> 8;
        tp[tid] = s; }
    __syncthreads();
}

struct CombRow { v2u x[8], ya[8], yb[8]; float wa, wb; };
__device__ __forceinline__ void comb_load(CombRow& R, int m, const bf16* X1, const bf16* Y, const unsigned* rte, const float* rtw, const LAS int* tpl, int lane) {
    const unsigned ra = rte[m * 2], rb = rte[m * 2 + 1]; R.wa = rtw[m * 2]; R.wb = rtw[m * 2 + 1];
    const int rowa = 256 * tpl[ra >> 16] + (int)(ra & 0xffffu), rowb = 256 * tpl[rb >> 16] + (int)(rb & 0xffffu);
    ld_row16(X1 + (size_t)m * D, lane, R.x); ld_row16(Y + (size_t)rowa * D, lane, R.ya); ld_row16(Y + (size_t)rowb * D, lane, R.yb);
}
__device__ __forceinline__ void comb_mix(const CombRow& R, const LAS float* vec, f32x4 (&v)[8], int lane) {
#pragma unroll
    for (int j = 0; j < 8; ++j) v[j] = bf4(R.x[j]);
    float mean, rstd; row_stats(v, mean, rstd);
#pragma unroll
    for (int j = 0; j < 8; ++j) { const f32x4 g1 = *((const LAS f32x4*)(vec + 5 * D) + lane + 64 * j), b1 = *((const LAS f32x4*)(vec + 6 * D) + lane + 64 * j), g = *((const LAS f32x4*)vec + lane + 64 * j);
        const f32x4 x1 = (v[j] - mean) * rstd * g1 + b1; v[j] = x1 * ALPHA + g * (bf4(R.ya[j]) * R.wa + bf4(R.yb[j]) * R.wb); }
}
__device__ __forceinline__ void comb_fin(f32x4 (&v)[8], int m, int l, const LAS float* vec, float* XO32, bf16* XO16, bf16* H, int lane) {
    float mean, rstd; row_stats(v, mean, rstd);
#pragma unroll
    for (int j = 0; j < 8; ++j) { const f32x4 g = *((const LAS f32x4*)(vec + D) + lane + 64 * j), bb = *((const LAS f32x4*)(vec + 2 * D) + lane + 64 * j); v[j] = (v[j] - mean) * rstd * g + bb; }
    if (l == DEPTH - 1) {
#pragma unroll
        for (int j = 0; j < 8; ++j) *((GAS f32x4*)(XO32 + (size_t)m * D) + lane + 64 * j) = v[j];
    } else { st_row16(XO16 + (size_t)m * D, lane, v);
        if (MK_IN_FP8) ln_mod_store(v, vec + 3 * D, vec + 4 * D, (bf16*)nullptr, lane, (unsigned char*)H + (size_t)m * D); else ln_mod_store(v, vec + 3 * D, vec + 4 * D, H + (size_t)m * D, lane); }
}
__device__ __forceinline__ void p9_combine(ArgsP A, int l, LAS unsigned char* lds, int vcu, int G, int tid, int lane, int wave) {
    unsigned char* ws = A->ws; const bf16* X1 = (const bf16*)(ws + WS_Z)  ; const bf16* Y = (const bf16*)(ws + WS_Y); bf16* H = (bf16*)(ws + WS_H);
    const float* mod = (const float*)(ws + WS_MOD) + (size_t)l * BATCH * D6; const float* modn = (const float*)(ws + WS_MOD) + (size_t)(l + 1 < DEPTH ? l + 1 : l) * BATCH * D6;
    const unsigned* rte = (const unsigned*)(ws + WS_ROUTE); const float* rtw = (const float*)(ws + WS_ROUTE + 256 * 1024);
    LAS float* vec = (LAS float*)(lds + RING_OFF);
    moe_table(A, l, lds, tid); const LAS int* tpl = (const LAS int*)(lds + MOE_OFF);
    for (int ch = vcu; ch < T / 64; ch += G) { const int r0 = ch * 64 + wave * 8, b = r0 / SEQ;
        { const float* const sv[7] = {mod + (size_t)b * D6 + 5 * D, A->ln2_g + (size_t)l * D, A->ln2_b + (size_t)l * D, modn + (size_t)b * D6 + D, modn + (size_t)b * D6, A->ln1_g + (size_t)l * D, A->ln1_b + (size_t)l * D};
          stage_vecs<7>(vec, sv, tid); }
        CombRow R; comb_load(R, r0, X1, Y, rte, rtw, tpl, lane);
        __syncthreads();
#pragma unroll 1
        for (int rr = 0; rr < 8; ++rr) {
            const LAS float* vr = vec; asm volatile("" : "+v"(vr));
            f32x4 v[8]; comb_mix(R, vr, v, lane);
            if (rr + 1 < 8) comb_load(R, r0 + rr + 1, X1, Y, rte, rtw, tpl, lane);
            comb_fin(v, r0 + rr, l, vr, A->out, (bf16*)(ws + WS_X2), H, lane);
        }
        __syncthreads();
    }
}

#define PH_BEGIN() ArgsP A = kargs(); unsigned char* ws = A->ws; int tid; asm volatile("v_mbcnt_lo_u32_b32 %0, -1, 0\n\tv_mbcnt_hi_u32_b32 %0, -1, %0" : "=v"(tid)); tid += wave0 * 64; const int lane = tid & 63, wave = __builtin_amdgcn_readfirstlane(tid >> 6); (void)lane; (void)wave; (void)ws
__global__ void __launch_bounds__(NTHR, 2) mk_fwd(Args args) {
    extern __shared__ __attribute__((aligned(16))) unsigned char lds_raw[];
    LAS unsigned char* lds = (LAS unsigned char*)lds_raw;
    volatile LAS unsigned* MISC = (volatile LAS unsigned*)(lds + MISC_OFF);
    const int G = gridDim.x; const int bx = blockIdx.x; const int vcu = (G % 8 == 0) ? (bx % 8) * (G / 8) + bx / 8 : bx;
    const int wave0 = __builtin_amdgcn_readfirstlane((int)threadIdx.x >> 6);
    for (int u = threadIdx.x; u < (LDS_BYTES - LDSCTL_OFF) / 4; u += NTHR) ((LAS unsigned*)(lds + LDSCTL_OFF))[u] = 0u;
    __syncthreads();
    XcdBarrier bar; bar.bar = (gu32*)(args.ws + WS_CTL) + CW_BAR; bar.x = 0; bar.st = nullptr;
    if (!MK_PER_PHASE) bar = xcd_barrier_post(bar.bar, MISC + 8, threadIdx.x == 0);
    const int lo = args.ph_lo, hi = args.ph_hi;
#ifndef MK_ATT_FOX
#define MK_ATT_FOX 1
#endif
#ifndef MK_ATT_SB
#define MK_ATT_SB 1
#endif
#ifndef MK_MASK
#define MK_MASK 0x3ff
#endif
#define EN(j) (((MK_MASK) >> (j)) & 1)
#ifndef MK_DUP
#define MK_DUP 0
#endif
#if MK_DUP
#define REP(j) for (int rep_ = 0, nrep_ = 1 + ((kargs()->dup >> (j)) & 1); rep_ < nrep_; ++rep_)
#else
#define REP(j)
#endif
#define IN(k) (lo <= (k) && (k) < hi)
#define SEAM(k) do { if (IN(k) && IN((k) + 1)) xcd_barrier(bar, tid == 0); } while (0)

    if (EN(0) && IN(0)) REP(0) { PH_BEGIN(); p0_prologue(A, lds, vcu, G, tid, lane, wave); SEAM(0); }
    if (EN(1) && IN(1)) REP(1) { PH_BEGIN(); p1_ln0(A, lds, vcu, G, tid, lane, wave); SEAM(1); }
#pragma unroll 1
    for (int l = 0; l < DEPTH; ++l) {
        const int pb = 2 + 8 * l;
        if (EN(2) && IN(pb)) REP(2) { PH_BEGIN();
            EpiProj E{(bf16*)(ws + WS_PROJ), (float*)(ws + WS_FLOG)};
#if MK_IN_FP8
            StaticSched S; S.init(T, NPROJ_PAD, D / 2, G, bx, ws + WS_WIN + (size_t)l * NPROJ_PAD * D);
            pg8::gemm_phase<EpiProj, StaticSched, true, true, 0, 0>(lds + RING_OFF, (const char*)(ws + WS_H), D / 2, S, E, tid);
#else
            StaticSched S; S.init(T, NPROJ_PAD, D, G, bx, (const bf16*)(ws + WS_WIN) + (size_t)l * NPROJ_PAD * D);
            pg8::gemm_phase<EpiProj, StaticSched, true>(lds + RING_OFF, (const char*)(ws + WS_H), D, S, E, tid);
#endif
            { pg8::Unit ux; if (!S.next((T / 256) * (NPROJ_PAD / 256) / G, ux)) convert_claim(A, l, 7, lds, tid, wave); }
            SEAM(pb);
        }
        if (EN(3) && IN(pb + 1)) REP(3) { PH_BEGIN();
            for (int u = vcu; u < BATCH * NFH; u += G) cum_unit(A, l, u, lds, tid, lane, wave);
            for (int u = vcu; u < T / 32; u += G) conv_unit(A, l, u, lds, tid, lane, wave);
            SEAM(pb + 1);
        }
#if MK_DUP
        if (EN(4) && IN(pb + 2)) for (int rep_ = 0, nrep_ = 1 + (((kargs()->dup >> 10) & 3) != 0); rep_ < nrep_; ++rep_) { PH_BEGIN(); const int dupa = (A->dup >> 10) & 3;
#else
        if (EN(4) && IN(pb + 2)) { PH_BEGIN(); constexpr int rep_ = 0, dupa = 0;
#endif
            const attn_body::bf16* P = (const attn_body::bf16*)(ws + WS_PROJ); unsigned char* MIX = ws + WS_MIX; const float* cum = (const float*)(ws + WS_CUM);
            gu32* qctr = (gu32*)(ws + WS_CTL) + CW_Q + (l * 2 + rep_) * 64; LAS unsigned* tk = (LAS unsigned*)(lds + MISC_OFF + 64);
            for (;;) {
                if (tid == 0) *tk = __hip_atomic_fetch_add(qctr, 1u, RLX_AGENT);
                __syncthreads();
                const unsigned idx = (unsigned)__builtin_amdgcn_readfirstlane((int)*tk);
                __syncthreads();
                if (idx >= 1536u) break;
                const int qb = 15 - (int)(idx / 96u), r = (int)(idx % 96u);
                if (r < 64) { const int b = r / NFH, h = r % NFH;
                    if (MK_ATT_FOX && (rep_ == 0 || (dupa & 1))) attn_body::fox_unit<8>(b, qb, P + C_QFX + h * 64, P + C_KFX + h * 64, P + C_VFX + h * 64, MIX + O_FX + h * 64, cum + (size_t)r * SEQ, (const float*)(ws + WS_MOD + 768 * 1024) + r * 64, (char*)lds_raw + RING_OFF, tid);
                } else { const int bh = r - 64, b = bh / 8, h = bh % 8;
                    if (MK_ATT_SB && (rep_ == 0 || (dupa & 2))) attn_body::sb_unit(b, qb, P + C_QSB + h * 64, P + C_KSB + h * 64, P + C_VSB + h * 64, MIX + O_SB + h * 64, (char*)lds_raw + RING_OFF, tid);
                }
                if (rep_ == 0) { static_assert(N_XTILE == 1536 * 4, "four conversion tiles per attention ticket cover every tile"); convert_claim(A, l, 4, lds, tid, wave); }
            }
            SEAM(pb + 2);
        }
        if (EN(5) && IN(pb + 3)) REP(5) { PH_BEGIN();
            StaticSched S; S.init(T, D, D / 2, G, bx, ws + WS_WOUT + (size_t)l * D * D);
            EpiZ E{l == 0 ? A->x : (const float*)nullptr, (const bf16*)(ws + WS_X2), (const float*)(ws + WS_MOD) + (size_t)l * BATCH * D6 + 2 * D, (bf16*)(ws + WS_Z)};
            pg8::gemm_phase<EpiZ, StaticSched, false, true, 0, 0>(lds + RING_OFF, (const char*)(ws + WS_MIX), D / 2, S, E, tid);
            SEAM(pb + 3);
        }
        if (EN(6) && IN(pb + 4)) { PH_BEGIN(); p6_ln_route(A, l, lds, vcu, G, tid, lane, wave); SEAM(pb + 4); }
        if (EN(7) && IN(pb + 5)) REP(7) { PH_BEGIN();
            moe_table(A, l, lds, tid);
#if MK_GU_FP8
            MoeSched<true> S{(const LAS int*)(lds + MOE_OFF), (const LAS int*)(lds + MOE_OFF) + 40, (const int*)(ws + WS_LIST), G, bx, D / 2, (const char*)(ws + WS_WGU) + (size_t)l * NEXP * 2048 * 2048, (size_t)2048 * 2048};
            EpiHid E{ws + WS_HID};
            pg8::gemm_phase<EpiHid, MoeSched<true>, true, true, 0, 0>(lds + RING_OFF, (const char*)(ws + WS_H8), D / 2, S, E, tid);
            if (l + 1 < DEPTH) { const int total = ((const LAS int*)(lds + MOE_OFF))[NEXP] * 8; if (total % G != 0 && bx >= total % G) convert_claim(A, l + 1, 6, lds, tid, wave); }
#else
            MoeSched<true> S{(const LAS int*)(lds + MOE_OFF), (const LAS int*)(lds + MOE_OFF) + 40, (const int*)(ws + WS_LIST), G, bx, D, (const char*)(ws + WS_WGU) + (size_t)l * NEXP * 2048 * 2048 * 2, (size_t)2048 * 2048 * 2};
            EpiHid E{ws + WS_HID};
            pg8::gemm_phase<EpiHid, MoeSched<true>, true>(lds + RING_OFF, (const char*)(ws + WS_H), D, S, E, tid);
#endif
            SEAM(pb + 5);
        }
        if (EN(8) && IN(pb + 6)) REP(8) { PH_BEGIN();
            moe_table(A, l, lds, tid);
            MoeSched<false> S{(const LAS int*)(lds + MOE_OFF), (const LAS int*)(lds + MOE_OFF) + 40, (const int*)(ws + WS_LIST), G, bx, DEXP / 2, (const char*)(ws + WS_WDN) + (size_t)l * NEXP * 2048 * 1024, (size_t)2048 * 1024};
            EpiY E{(bf16*)(ws + WS_Y)};
            pg8::gemm_phase<EpiY, MoeSched<false>, true, true, 0, 0>(lds + RING_OFF, (const char*)(ws + WS_HID), DEXP / 2, S, E, tid);
            if (l + 1 < DEPTH) { const int total = ((const LAS int*)(lds + MOE_OFF))[NEXP] * 8; if (total % G != 0 && bx >= total % G) convert_claim(A, l + 1, 4, lds, tid, wave); }
            SEAM(pb + 6);
        }
        if (EN(9) && IN(pb + 7)) REP(9) { PH_BEGIN(); p9_combine(A, l, lds, vcu, G, tid, lane, wave); SEAM(pb + 7); }
    }
#undef IN
#undef SEAM
}

extern "C" void kernel_launch(void* const* d_in, const int* in_sizes, int n_in, void* d_out, int out_size, void* d_ws, size_t ws_size, hipStream_t stream) {
    static int grid = 0;
    if (grid == 0) {
        if (n_in != 22 || in_sizes[0] != T * D || out_size != T * D || ws_size < WS_END) { fprintf(stderr, "kernel_launch: unexpected shapes / workspace (n_in %d, in0 %d, out %d, ws %zu, need %zu); nothing launched\n", n_in, n_in > 0 ? in_sizes[0] : -1, out_size, ws_size, (size_t)WS_END); grid = -1; return; }
        int dev = 0, cus = 0, per_cu = 0;
        if (hipGetDevice(&dev) != hipSuccess || hipDeviceGetAttribute(&cus, hipDeviceAttributeMultiprocessorCount, dev) != hipSuccess) { grid = -1; return; }
        if (hipFuncSetAttribute((const void*)mk_fwd, hipFuncAttributeMaxDynamicSharedMemorySize, LDS_BYTES) != hipSuccess) { fprintf(stderr, "kernel_launch: hipFuncSetAttribute failed\n"); grid = -1; return; }
        if (hipOccupancyMaxActiveBlocksPerMultiprocessor(&per_cu, (const void*)mk_fwd, NTHR, LDS_BYTES) != hipSuccess || per_cu < 1) fprintf(stderr, "kernel_launch: occupancy query reports %d blocks per CU\n", per_cu);
        (void)hipGetLastError();
        grid = cus;
    }
    if (grid < 0) return;
    if (hipMemsetAsync((char*)d_ws + WS_CTL, 0, CTL_ZERO_BYTES, stream) != hipSuccess) return;
    Args a{};
    const float** ap = (const float**)&a;
    for (int i = 0; i < 22; ++i) ap[i] = (const float*)d_in[i];
    a.out = (float*)d_out; a.ws = (unsigned char*)d_ws; a.dup = MK_DUP; a.pad = 0;
#if MK_PER_PHASE
    for (int p = 0; p < NPHASE; ++p) { a.ph_lo = p; a.ph_hi = p + 1; hipLaunchKernelGGL(mk_fwd, dim3(grid), dim3(NTHR), LDS_BYTES, stream, a); }
#else
    a.ph_lo = 0; a.ph_hi = NPHASE; hipLaunchKernelGGL(mk_fwd, dim3(grid), dim3(NTHR), LDS_BYTES, stream, a);
#endif
}
```
